# Optimizing an MI355X kernel written in HIP

```python
import math
import jax, jax.numpy as jnp
from jax import lax
import numpy as np

D_MODEL = 2048
BATCH = 8
SEQ = 4096
DEPTH = 4
DEC_BATCH = 2
DEC_SEQ = 4096
PAST_LEN = 128

GRID_W = 64
NA_HEAD_DIM = 64
NA_HEADS = D_MODEL // (2 * NA_HEAD_DIM)
NA_WIN_ROWS = 8
NA_WIN_COLS = 16
NA_QBLK_COLS = 16
SW_HEAD_DIM = 64
SW_Q_HEADS = D_MODEL // (2 * SW_HEAD_DIM)
SW_KV_HEADS = SW_Q_HEADS // 4
SW_RADIUS = 128
DIL_PAIRS = ((128, 1), (512, 4), (2048, 16))
DIL_HEAD_DIM = 64
DIL_HEADS = D_MODEL // (2 * DIL_HEAD_DIM)
ROPE_THETA = 500000.0
ROPE_FRACTION = 4
FFN_HIDDEN = ((8 * D_MODEL + 3 * 256 - 1) // (3 * 256)) * 256
RMS_EPS = 1e-6
NEG_INF = -1e30

A_W = NA_HEADS * NA_HEAD_DIM
B_QW = SW_Q_HEADS * SW_HEAD_DIM
B_KVW = SW_KV_HEADS * SW_HEAD_DIM
AB_IN = 3 * A_W + B_QW + 2 * B_KVW
AB_OUT = A_W + B_QW
C_W = DIL_HEADS * DIL_HEAD_DIM
C_IN = len(DIL_PAIRS) * 3 * C_W
C_OUT = C_W

kernel_name = "hybrid_natten_swa_dilated_encoder"


def rms_norm(x, g):
    xf = x.astype(jnp.float32)
    y = xf * lax.rsqrt(jnp.mean(xf * xf, axis=-1, keepdims=True) + RMS_EPS)
    return (y * g.astype(jnp.float32)).astype(x.dtype)


def rotary(x, pos):
    rot = x.shape[-1] // ROPE_FRACTION
    half = rot // 2
    inv = jnp.exp(-math.log(ROPE_THETA) * jnp.arange(half, dtype=jnp.float32) * (2.0 / rot))
    ang = pos[:, None] * inv[None, :]
    cos = jnp.cos(ang)[:, None, :].astype(x.dtype)
    sin = jnp.sin(ang)[:, None, :].astype(x.dtype)
    x1 = x[..., :half]
    x2 = x[..., half:rot]
    return jnp.concatenate([x1 * cos - x2 * sin, x2 * cos + x1 * sin, x[..., rot:]], axis=-1)


def banded_attention(q, k, v, radius, sink=None):
    n, L, hq, dh = q.shape
    hk = k.shape[2]
    g = hq // hk
    blk = radius
    nb = -(-L // blk)
    lp = nb * blk
    pad = lp - L
    qb = jnp.pad(q, ((0, 0), (0, pad), (0, 0), (0, 0))).reshape(n, nb, blk, hk, g, dh)

    def key_windows(t):
        tp = jnp.pad(t, ((0, 0), (blk, pad + blk), (0, 0), (0, 0))).reshape(n, nb + 2, blk, hk, dh)
        return jnp.concatenate([tp[:, :-2], tp[:, 1:-1], tp[:, 2:]], axis=2)

    kw, vw = key_windows(k), key_windows(v)
    qpos = jnp.arange(lp).reshape(nb, blk)
    kpos = (jnp.arange(nb)[:, None] - 1) * blk + jnp.arange(3 * blk)[None, :]
    kp = kpos[:, None, :]
    mask = (jnp.abs(qpos[:, :, None] - kp) <= radius) & (kp >= 0) & (kp < L)
    s = jnp.einsum('nbikgd,nbukd->nbkgiu', qb, kw).astype(jnp.float32) * (dh ** -0.5)
    s = jnp.where(mask[None, :, None, None], s, NEG_INF)
    m = jnp.max(s, axis=-1)
    if sink is not None:
        sk = sink.astype(jnp.float32).reshape(hk, g)[None, None, :, :, None]
        m = jnp.maximum(m, sk)
    p = jnp.exp(s - m[..., None])
    den = jnp.sum(p, axis=-1)
    if sink is not None:
        den = den + jnp.exp(sk - m)
    o = jnp.einsum('nbkgiu,nbukd->nbikgd', (p / den[..., None]).astype(v.dtype), vw)
    lse = jnp.moveaxis(m + jnp.log(den), -1, 2)
    o = o.reshape(n, lp, hq, dh)[:, :L]
    lse = lse.reshape(n, lp, hq)[:, :L]
    return o, lse


def dilated_attention(q, k, v, window, dilation):
    b, L, h, dh = q.shape
    radius = window // (2 * dilation)
    lm = L // dilation

    def split(t):
        return t.reshape(b, lm, dilation, h, dh).transpose(0, 2, 1, 3, 4).reshape(b * dilation, lm, h, dh)

    o, lse = banded_attention(split(q), split(k), split(v), radius)
    o = o.reshape(b, dilation, lm, h, dh).transpose(0, 2, 1, 3, 4).reshape(b, L, h, dh)
    lse = lse.reshape(b, dilation, lm, h).transpose(0, 2, 1, 3).reshape(b, L, h)
    return o, lse


def neighbourhood_attention(q, k, v, rpb):
    b, L, h, dh = q.shape
    rows = L // GRID_W
    kh = min(NA_WIN_ROWS, rows)
    kw = NA_WIN_COLS
    qr = math.gcd(rows, NA_WIN_ROWS)
    qc = NA_QBLK_COLS
    kr = min(kh + qr - 1, rows)
    kc = min(kw + qc - 1, GRID_W)
    nrb, ncb = rows // qr, GRID_W // qc
    r0 = jnp.arange(nrb) * qr
    c0 = jnp.arange(ncb) * qc
    krow = jnp.clip(r0 - kh // 2, 0, rows - kr)[:, None] + jnp.arange(kr)[None, :]
    kcol = jnp.clip(c0 - kw // 2, 0, GRID_W - kc)[:, None] + jnp.arange(kc)[None, :]
    qrow = r0[:, None] + jnp.arange(qr)[None, :]
    qcol = c0[:, None] + jnp.arange(qc)[None, :]
    rs = jnp.clip(qrow - kh // 2, 0, rows - kh)[:, :, None]
    cs = jnp.clip(qcol - kw // 2, 0, GRID_W - kw)[:, :, None]
    row_ok = (krow[:, None, :] >= rs) & (krow[:, None, :] < rs + kh)
    col_ok = (kcol[:, None, :] >= cs) & (kcol[:, None, :] < cs + kw)
    dr = jnp.clip(krow[:, None, :] - qrow[:, :, None] + NA_WIN_ROWS - 1, 0, 2 * NA_WIN_ROWS - 2)
    dc = jnp.clip(kcol[:, None, :] - qcol[:, :, None] + NA_WIN_COLS - 1, 0, 2 * NA_WIN_COLS - 2)
    bias = rpb.astype(jnp.float32)[:, dr[:, None, :, None, :, None], dc[None, :, None, :, None, :]]
    mask = row_ok[:, None, :, None, :, None] & col_ok[None, :, None, :, None, :]
    bias = jnp.moveaxis(jnp.where(mask[None], bias, NEG_INF), 0, 2)

    qg = q.reshape(b, nrb, qr, ncb, qc, h, dh)

    def gather(t):
        t = t.reshape(b, rows, GRID_W, h, dh)
        t = jnp.take(t, krow, axis=1)
        return jnp.take(t, kcol, axis=3)

    kg, vg = gather(k), gather(v)
    s = jnp.einsum('bRiCjhd,bRuCwhd->bRChijuw', qg, kg).astype(jnp.float32) * (dh ** -0.5) + bias[None]
    p = jax.nn.softmax(s.reshape(s.shape[:-2] + (kr * kc,)), axis=-1).reshape(s.shape)
    o = jnp.einsum('bRChijuw,bRuCwhd->bRiCjhd', p.astype(v.dtype), vg)
    return o.reshape(b, L, h, dh)


def ab_mixer(h, w_in, w_out, rpb, sink, pos):
    b, L, _ = h.shape
    proj = jnp.einsum('bld,de->ble', h, w_in)
    o3 = 3 * A_W
    o4 = o3 + B_QW
    o5 = o4 + B_KVW
    qa = proj[..., :A_W].reshape(b, L, NA_HEADS, NA_HEAD_DIM)
    ka = proj[..., A_W:2 * A_W].reshape(b, L, NA_HEADS, NA_HEAD_DIM)
    va = proj[..., 2 * A_W:o3].reshape(b, L, NA_HEADS, NA_HEAD_DIM)
    qb = rotary(proj[..., o3:o4].reshape(b, L, SW_Q_HEADS, SW_HEAD_DIM), pos)
    kb = rotary(proj[..., o4:o5].reshape(b, L, SW_KV_HEADS, SW_HEAD_DIM), pos)
    vb = proj[..., o5:].reshape(b, L, SW_KV_HEADS, SW_HEAD_DIM)
    out_a = neighbourhood_attention(qa, ka, va, rpb)
    out_b, _ = banded_attention(qb, kb, vb, SW_RADIUS, sink)
    cat = jnp.concatenate([out_a.reshape(b, L, A_W), out_b.reshape(b, L, B_QW)], axis=-1)
    return jnp.einsum('ble,ed->bld', cat, w_out)


def c_mixer(h, w_in, w_out, pos):
    b, L, _ = h.shape
    proj = jnp.einsum('bld,de->ble', h, w_in).reshape(b, L, len(DIL_PAIRS), 3, DIL_HEADS, DIL_HEAD_DIM)
    outs, lses = [], []
    for gi, (win, dil) in enumerate(DIL_PAIRS):
        q = rotary(proj[:, :, gi, 0], pos)
        k = rotary(proj[:, :, gi, 1], pos)
        o, lse = dilated_attention(q, k, proj[:, :, gi, 2], win, dil)
        outs.append(o)
        lses.append(lse)
    wts = jax.nn.softmax(jnp.stack(lses, axis=0), axis=0)
    o = jnp.sum(wts[..., None] * jnp.stack(outs, axis=0).astype(jnp.float32), axis=0)
    return jnp.einsum('ble,ed->bld', o.astype(h.dtype).reshape(b, L, C_W), w_out)


def swiglu(h, wg, wu, wd):
    hid = jax.nn.silu(jnp.einsum('bld,df->blf', h, wg)) * jnp.einsum('bld,df->blf', h, wu)
    return jnp.einsum('blf,fd->bld', hid, wd)


def trunk(x, g_mix_pre, g_mix_post, g_ffn_pre, g_ffn_post, w_in_ab, w_out_ab, rpb_a,
          sink_b, w_in_c, w_out_c, w_gate, w_up, w_down):
    L = x.shape[1]
    pos = jnp.arange(L, dtype=jnp.float32)
    for layer in range(DEPTH):
        i = layer // 2
        hn = rms_norm(x, g_mix_pre[layer])
        if layer % 2 == 0:
            m = ab_mixer(hn, w_in_ab[i], w_out_ab[i], rpb_a[i], sink_b[i], pos)
        else:
            m = c_mixer(hn, w_in_c[i], w_out_c[i], pos)
        x = x + rms_norm(m, g_mix_post[layer])
        f = swiglu(rms_norm(x, g_ffn_pre[layer]), w_gate[layer], w_up[layer], w_down[layer])
        x = x + rms_norm(f, g_ffn_post[layer])
    return x


def setup_inputs(seed: int = 0) -> dict:
    key = jax.random.key(seed)
    ks = jax.random.split(key, 16)
    n_even = (DEPTH + 1) // 2
    n_odd = DEPTH // 2

    def w(k, shape, fan_in):
        return jax.random.normal(k, shape, jnp.float32) * (fan_in ** -0.5)

    def gain(k):
        return 1.0 + 0.05 * jax.random.normal(k, (DEPTH, D_MODEL), jnp.float32)

    return {
        "x_prompt": jax.random.normal(ks[0], (BATCH, SEQ, D_MODEL), jnp.float32),
        "x_sample": jax.random.normal(ks[1], (DEC_BATCH, DEC_SEQ, D_MODEL), jnp.float32),
        "g_mix_pre": gain(ks[2]),
        "g_mix_post": gain(ks[3]),
        "g_ffn_pre": gain(ks[4]),
        "g_ffn_post": gain(ks[5]),
        "w_in_ab": w(ks[6], (n_even, D_MODEL, AB_IN), D_MODEL),
        "w_out_ab": w(ks[7], (n_even, AB_OUT, D_MODEL), AB_OUT),
        "rpb_a": 0.1 * jax.random.normal(ks[8], (n_even, NA_HEADS, 2 * NA_WIN_ROWS - 1, 2 * NA_WIN_COLS - 1), jnp.float32),
        "sink_b": jax.random.normal(ks[9], (n_even, SW_Q_HEADS), jnp.float32),
        "w_in_c": w(ks[10], (n_odd, D_MODEL, C_IN), D_MODEL),
        "w_out_c": w(ks[11], (n_odd, C_OUT, D_MODEL), C_OUT),
        "w_gate": w(ks[12], (DEPTH, D_MODEL, FFN_HIDDEN), D_MODEL),
        "w_up": w(ks[13], (DEPTH, D_MODEL, FFN_HIDDEN), D_MODEL),
        "w_down": w(ks[14], (DEPTH, FFN_HIDDEN, D_MODEL), FFN_HIDDEN),
    }


def reference(x_prompt, x_sample, g_mix_pre, g_mix_post, g_ffn_pre, g_ffn_post, w_in_ab,
              w_out_ab, rpb_a, sink_b, w_in_c, w_out_c, w_gate, w_up, w_down):
    y_prompt = trunk(x_prompt, g_mix_pre, g_mix_post, g_ffn_pre, g_ffn_post, w_in_ab, w_out_ab,
                     rpb_a, sink_b, w_in_c, w_out_c, w_gate, w_up, w_down)
    y_sample = trunk(x_sample, g_mix_pre, g_mix_post, g_ffn_pre, g_ffn_post, w_in_ab, w_out_ab,
                     rpb_a, sink_b, w_in_c, w_out_c, w_gate, w_up, w_down)
    return (y_prompt, y_sample)
```

```cpp
#include <hip/hip_runtime.h>
#include <cstdio>
#include <cstdint>
#include <cmath>

#ifndef PROBE
#define PROBE 0
#endif
#ifndef MK_PER_PHASE
#define MK_PER_PHASE 0
#endif

constexpr int D = 2048, SEQ = 4096, NSEQ = 10, T = NSEQ * SEQ, FF = 5632, DEPTH = 4;
constexpr int N_AB = 4608, N_C = 9216, N_GU = 2 * FF;
constexpr float RMS_EPS = 1e-6f;
constexpr float LOG2E = 1.4426950408889634f;
constexpr float QSCALE = 0.125f * LOG2E;

constexpr size_t MiB = 1u << 20;
constexpr size_t WS_CTL = 0, CTL_ZERO_BYTES = 1 * MiB;
constexpr size_t WS_ROPE = 1 * MiB;
constexpr size_t WS_RSTD = 1 * MiB + 256 * 1024;
constexpr size_t WS_LSE = 2 * MiB;
constexpr size_t WS_WIN = 8 * MiB;
constexpr size_t WS_WOUT = 44 * MiB;
constexpr size_t WS_WGU = 52 * MiB;
constexpr size_t WS_WD = 96 * MiB;
constexpr size_t WS_XB = 120 * MiB;
constexpr size_t WS_BIG = 280 * MiB;
constexpr size_t WS_END = 1000 * MiB;
constexpr int CW_BAR = 4096;

constexpr int RING_OFF = 0, RING_BYTES = 131072;
constexpr int LDSCTL_OFF = RING_BYTES, MISC_OFF = LDSCTL_OFF + 320;
constexpr int BIAS_OFF = LDSCTL_OFF + 1024;
constexpr int RSB_OFF = LDSCTL_OFF + 4096;
constexpr int LDS_BYTES = 163840;
constexpr int NWAVES = 8;

#define GAS __attribute__((address_space(1)))
#define LAS __attribute__((address_space(3)))
typedef unsigned short bf16_t;
typedef short bf16x8 __attribute__((ext_vector_type(8)));
typedef float f32x4 __attribute__((ext_vector_type(4)));
typedef unsigned u32x4 __attribute__((ext_vector_type(4)));
typedef unsigned u32x2 __attribute__((ext_vector_type(2)));
typedef float f32x16 __attribute__((ext_vector_type(16)));
typedef short s16x4 __attribute__((ext_vector_type(4)));

__device__ __forceinline__ unsigned f2bf(float f) { unsigned u = __builtin_bit_cast(unsigned, f); return (u + 0x7fffu + ((u >> 16) & 1u)) >> 16; }
__device__ __forceinline__ unsigned pk2(float lo, float hi) { return f2bf(lo) | (f2bf(hi) << 16); }
__device__ __forceinline__ float bflo(unsigned w) { return __builtin_bit_cast(float, w << 16); }
__device__ __forceinline__ float bfhi(unsigned w) { return __builtin_bit_cast(float, w & 0xffff0000u); }
__device__ __forceinline__ unsigned cvt_pk_bf16(float lo, float hi) { unsigned r; asm volatile("v_cvt_pk_bf16_f32 %0, %1, %2" : "=v"(r) : "v"(lo), "v"(hi)); return r; }
__device__ __forceinline__ int fresh_lane() { int l; asm volatile("v_mbcnt_lo_u32_b32 %0, -1, 0\n\tv_mbcnt_hi_u32_b32 %0, -1, %0" : "=v"(l)); return l; }
__device__ __forceinline__ float wave_sum(float v) {
#pragma unroll
    for (int o = 1; o < 64; o <<= 1) v += __shfl_xor(v, o);
    return v;
}
__device__ __forceinline__ float wave_max(float v) {
#pragma unroll
    for (int o = 1; o < 64; o <<= 1) v = fmaxf(v, __shfl_xor(v, o));
    return v;
}

namespace pg8 {
constexpr int BM = 256, BK = 64, HALF = 128, HTB = HALF * BK * 2, STAGE_BYTES = 8 * HTB, NXCD = 8, WGM = 8;
__host__ __device__ __forceinline__ int lds_byte(int r, int c) { const int st = (r >> 4) * 2 + (c >> 5), rr = r & 15, cc = c & 31, ob = rr * 64 + cc * 2; return st * 1024 + (ob ^ (((ob >> 9) & 1) << 5)); }
__host__ __device__ __forceinline__ void stage_rc(int b, int& R, int& C) { const int st = b / 1024, sb = b % 1024, swz = sb ^ (((sb >> 9) & 1) << 5); R = (st >> 1) * 16 + swz / 64; C = (st & 1) * 32 + (swz % 64) / 2; }
__host__ __device__ __forceinline__ int perm32(int rho) { const int n = rho >> 4, i = rho & 15; return 8 * (i >> 2) + 4 * n + (i & 3); }

struct Unit { int pm, pn; };
struct Gemm { const bf16_t* A; const bf16_t* Bt; int M, N, K, lda, ldb; size_t kstepA, kstepB; };

struct StaticOrder {
    int nM, nN, nwg, G, c;
    __device__ void init(int M, int N, int G_, int c_) { nM = M / BM; nN = N / BM; nwg = nM * nN; G = G_; c = c_; }
    __device__ bool next(int i, Unit& u) const {
        const int per = G / NXCD; const long L = (G % NXCD == 0) ? (long)i * G + (long)(c % NXCD) * per + c / NXCD : (long)i * G + c;
        if (L >= nwg) return false;
        const int wgid = (int)L;
        const int nig = WGM * nN, gid = wgid / nig, fm = gid * WGM, gsz = (nM - fm) < WGM ? (nM - fm) : WGM;
        u.pm = fm + ((wgid % nig) % gsz); u.pn = (wgid % nig) / gsz; return true;
    }
    __device__ __forceinline__ void a_ready(const Unit&) const {}
    __device__ __forceinline__ void done(const Unit&) const {}
};

template <bool NS> struct EpiPlainT {
    static constexpr bool PERM = true, USES_RS = false;
    bf16_t* O; int ldc;
    __device__ __forceinline__ void operator()(const f32x4 (&acc)[2][2][4][2], const Unit& u, int wr, int wc, int fr, int fq, const LAS float*) const {
        const int row0 = u.pm * BM + wr * 64 + fr, col0 = u.pn * BM + wc * 32 + 8 * fq;
#pragma unroll
        for (int ai = 0; ai < 2; ++ai)
#pragma unroll
            for (int m = 0; m < 4; ++m) { bf16_t* rowp = O + (size_t)(row0 + ai * HALF + m * 16) * ldc + col0;
#pragma unroll
                for (int bj = 0; bj < 2; ++bj) { const f32x4 v0 = acc[ai][bj][m][0], v1 = acc[ai][bj][m][1];
                    u32x4 w; w.x = cvt_pk_bf16(v0[0], v0[1]); w.y = cvt_pk_bf16(v0[2], v0[3]); w.z = cvt_pk_bf16(v1[0], v1[1]); w.w = cvt_pk_bf16(v1[2], v1[3]);
                    if (NS) asm volatile("" :: "v"(w)); else *(u32x4*)(rowp + bj * HALF) = w; } }
    }
};
typedef EpiPlainT<false> EpiPlain;
template <bool NS> struct EpiProjT {
    static constexpr bool PERM = true, USES_RS = true;
    bf16_t* O; const float* rstd; unsigned long long ropemask; float r0, r1, r2, r3, r4, r5, r6, r7;
    __device__ __forceinline__ void operator()(const f32x4 (&acc)[2][2][4][2], const Unit& u, int wr, int wc, int fr, int fq, const LAS float* rsl) const {
        const int row0 = u.pm * BM + wr * 64 + fr;
        const size_t sl0 = (size_t)(u.pn * 4 + (wc >> 1)) * T;
        const int d0 = (wc & 1) * 32 + 8 * fq;
        const bool rotw = (((ropemask >> u.pn) & 1ull) != 0ull) && ((wc & 1) == 0);
        float rs[2][4];
#pragma unroll
        for (int ai = 0; ai < 2; ++ai)
#pragma unroll
            for (int m = 0; m < 4; ++m) rs[ai][m] = rsl[ai * HALF + wr * 64 + m * 16 + fr];
        const f32x4 iv = fq == 0 ? (f32x4){r0, r1, r2, r3} : (f32x4){r4, r5, r6, r7};
#pragma unroll
        for (int ai = 0; ai < 2; ++ai)
#pragma unroll
            for (int m = 0; m < 4; ++m) { const int row = row0 + ai * HALF + m * 16; bf16_t* rowp = O + (sl0 + row) * 64 + d0;
                f32x4 c4 = (f32x4){1.f, 1.f, 1.f, 1.f}, s4 = (f32x4){0.f, 0.f, 0.f, 0.f};
                if (rotw) { const float pos = (float)(row & (SEQ - 1));
#pragma unroll
                    for (int i = 0; i < 4; ++i) { const float rev = __builtin_amdgcn_fractf(pos * iv[i]); const float c = __builtin_amdgcn_cosf(rev), sn = __builtin_amdgcn_sinf(rev);
                        c4[i] = fq < 2 ? c : 1.f; s4[i] = fq < 2 ? sn : 0.f; } }
#pragma unroll
                for (int bj = 0; bj < 2; ++bj) { const f32x4 a = acc[ai][bj][m][0] * rs[ai][m], b = acc[ai][bj][m][1] * rs[ai][m];
                    const f32x4 v0 = a * c4 - b * s4, v1 = b * c4 + a * s4;
                    u32x4 w; w.x = cvt_pk_bf16(v0[0], v0[1]); w.y = cvt_pk_bf16(v0[2], v0[3]); w.z = cvt_pk_bf16(v1[0], v1[1]); w.w = cvt_pk_bf16(v1[2], v1[3]);
                    if (NS) asm volatile("" :: "v"(w)); else *(u32x4*)(rowp + (size_t)bj * 2 * T * 64) = w; } }
    }
};
typedef EpiProjT<false> EpiProj;
template <bool NS> struct EpiSwiGLUT {
    static constexpr bool PERM = true, USES_RS = true;
    bf16_t* O; int ldc; const float* rstd;
    __device__ __forceinline__ void operator()(const f32x4 (&acc)[2][2][4][2], const Unit& u, int wr, int wc, int fr, int fq, const LAS float* rsl) const {
        const int row0 = u.pm * BM + wr * 64 + fr;
        bf16_t* Ob = O + (size_t)(2 * u.pn + (wc >> 1)) * T * 64 + (wc & 1) * 32 + 8 * fq;
        float rsv[2][4];
#pragma unroll
        for (int ai = 0; ai < 2; ++ai)
#pragma unroll
            for (int m = 0; m < 4; ++m) rsv[ai][m] = rsl[ai * HALF + wr * 64 + m * 16 + fr];
#pragma unroll
        for (int ai = 0; ai < 2; ++ai)
#pragma unroll
            for (int m = 0; m < 4; ++m) { const int row = row0 + ai * HALF + m * 16; const float rs = rsv[ai][m];
                float h[8];
#pragma unroll
                for (int n = 0; n < 2; ++n)
#pragma unroll
                    for (int j = 0; j < 4; ++j) { const float g = acc[ai][0][m][n][j] * rs, up = acc[ai][1][m][n][j] * rs;
                        const float sg = __builtin_amdgcn_rcpf(1.0f + __builtin_amdgcn_exp2f(-g * LOG2E)); h[n * 4 + j] = g * sg * up; }
                u32x4 w; w.x = cvt_pk_bf16(h[0], h[1]); w.y = cvt_pk_bf16(h[2], h[3]); w.z = cvt_pk_bf16(h[4], h[5]); w.w = cvt_pk_bf16(h[6], h[7]);
                if (NS) asm volatile("" :: "v"(w)); else *(u32x4*)(Ob + (size_t)row * 64) = w; }
    }
};
typedef EpiSwiGLUT<false> EpiSwiGLU;

struct EpiNone {
    static constexpr bool PERM = true, USES_RS = false;
    __device__ __forceinline__ void operator()(const f32x4 (&acc)[2][2][4][2], const Unit&, int, int, int, int, const LAS float*) const {
#pragma unroll
        for (int a = 0; a < 2; ++a)
#pragma unroll
            for (int b = 0; b < 2; ++b)
#pragma unroll
                for (int m = 0; m < 4; ++m)
#pragma unroll
                    for (int n = 0; n < 2; ++n) asm volatile("" :: "v"(acc[a][b][m][n]));
    }
};
template <class Epi, class Sched, bool ALIGN_EPI>
__device__ __forceinline__ void gemm_phase(LAS unsigned char* lds, const Gemm g, const Sched& S, const Epi& E, int wid) {
    const int lane = fresh_lane(), tid = wid * 64 + lane, wr = wid >> 2, wc = wid & 3, fr = lane & 15, fq = lane >> 4;
    const int K = g.K, nt = K / BK, lda = g.lda, ldb = g.ldb;
    unsigned voffA[2], voffB[2];
#pragma unroll
    for (int i = 0; i < 2; ++i) { int R, C; stage_rc(tid * 16 + i * 8192, R, C); const int Rb = Epi::PERM ? ((R & ~31) + perm32(R & 31)) : R;
        voffA[i] = (unsigned)(R * lda + C) * 2u; voffB[i] = (unsigned)(Rb * ldb + C) * 2u; }
    const size_t kstepA = g.kstepA, kstep = g.kstepB;
    const size_t hstepA = (size_t)HALF * lda * 2, hstepB = (size_t)HALF * ldb * 2;
    const size_t tstepA = 2 * hstepA, tstepB = 2 * hstepB;
    const unsigned ldsw = (unsigned)wid * 1024u;
    const int aoff = lds_byte(wr * 64 + fr, fq * 8), boff = lds_byte(wc * 32 + fr, fq * 8);
#define PG8_SA(b, h) (((b) * 2 + (h)) * HTB)
#define PG8_SB(b, h) ((4 + (b) * 2 + (h)) * HTB)
#define PG8_STAGE(bufoff, gbase, voff) do { _Pragma("unroll") for (int _i = 0; _i < 2; ++_i) \
        __builtin_amdgcn_global_load_lds((const unsigned*)((const char*)(gbase) + (voff)[_i]), (LAS unsigned*)(lds + (bufoff) + ldsw + _i * 8192), 16, 0, 0); } while (0)
#define PG8_LDA(dst, b, h) do { _Pragma("unroll") for (int m = 0; m < 4; ++m) _Pragma("unroll") for (int k = 0; k < 2; ++k) dst[m][k] = *(const LAS bf16x8*)(lds + PG8_SA(b, h) + aoff + m * 2048 + k * 1024); } while (0)
#define PG8_LDB(dst, b, h) do { _Pragma("unroll") for (int n = 0; n < 2; ++n) _Pragma("unroll") for (int k = 0; k < 2; ++k) dst[n][k] = *(const LAS bf16x8*)(lds + PG8_SB(b, h) + boff + n * 2048 + k * 1024); } while (0)
#define PG8_MMA(ai, bj, At, Bt) do { __builtin_amdgcn_s_setprio(1); _Pragma("unroll") for (int m = 0; m < 4; ++m) _Pragma("unroll") for (int n = 0; n < 2; ++n) _Pragma("unroll") for (int k = 0; k < 2; ++k) \
        acc[ai][bj][m][n] = __builtin_amdgcn_mfma_f32_16x16x32_bf16(Bt[n][k], At[m][k], acc[ai][bj][m][n], 0, 0, 0); __builtin_amdgcn_s_setprio(0); } while (0)
#define PG8_WAIT_V(n) asm volatile("s_waitcnt vmcnt(" #n ")" ::: "memory")
#define PG8_WAIT_L(n) asm volatile("s_waitcnt lgkmcnt(" #n ")" ::: "memory")
#define PG8_BAR __builtin_amdgcn_s_barrier()
#define PG8_SCHED __builtin_amdgcn_sched_barrier(0)
    Unit cur, nxt; int ui = 0;
    if (!S.next(0, cur)) return;
    f32x4 acc[2][2][4][2];
#pragma unroll
    for (int a = 0; a < 2; ++a)
#pragma unroll
        for (int b = 0; b < 2; ++b)
#pragma unroll
            for (int m = 0; m < 4; ++m)
#pragma unroll
                for (int n = 0; n < 2; ++n) acc[a][b][m][n] = (f32x4){0.f, 0.f, 0.f, 0.f};
    bf16x8 At[4][2], B0[2][2], B1[2][2];
    const char* cA = (const char*)g.A + (size_t)cur.pm * tstepA; const char* cB = (const char*)g.Bt + (size_t)cur.pn * tstepB;
    LAS unsigned char* rsb = lds + (RSB_OFF - RING_OFF) + wid * 2048;
#define PG8_RS_STAGE(pm_, buf_) __builtin_amdgcn_global_load_lds((const unsigned*)(E.rstd + (size_t)(pm_) * BM + lane * 4), (LAS unsigned*)(rsb + (buf_) * 1024), 16, 0, 0)
    if constexpr (Epi::USES_RS) PG8_RS_STAGE(cur.pm, 0);
    S.a_ready(cur);
    PG8_STAGE(PG8_SB(0, 0), cB, voffB); PG8_STAGE(PG8_SB(0, 1), cB + hstepB, voffB); PG8_STAGE(PG8_SA(0, 0), cA, voffA); PG8_STAGE(PG8_SA(0, 1), cA + hstepA, voffA);
    if (wr == 1) PG8_BAR;
    PG8_WAIT_V(2); PG8_BAR;
    PG8_STAGE(PG8_SB(1, 0), cB + kstep, voffB); PG8_STAGE(PG8_SA(1, 0), cA + kstepA, voffA); PG8_STAGE(PG8_SB(1, 1), cB + hstepB + kstep, voffB);
    PG8_WAIT_V(6); PG8_BAR;
    for (;;) {
        const bool has_next = S.next(ui + 1, nxt);
        const char* nA = has_next ? (const char*)g.A + (size_t)nxt.pm * tstepA : cA; const char* nB = has_next ? (const char*)g.Bt + (size_t)nxt.pn * tstepB : cB;
        for (int t = 0; t < nt; t += 2) {
            const bool last = (t == nt - 2);
            const char* a1 = cA + (size_t)(t + 1) * kstepA;
            const char* a2 = last ? nA : cA + (size_t)(t + 2) * kstepA; const char* b2 = last ? nB : cB + (size_t)(t + 2) * kstep;
            const char* a3 = a2 + kstepA; const char* b3 = b2 + kstep;
            if (last && has_next) S.a_ready(nxt);
            PG8_LDB(B0, 0, 0); PG8_LDB(B1, 0, 1); PG8_SCHED; PG8_LDA(At, 0, 0); PG8_STAGE(PG8_SA(1, 1), a1 + hstepA, voffA);
            PG8_WAIT_V(8); PG8_WAIT_L(0); PG8_BAR; PG8_MMA(0, 0, At, B0); PG8_MMA(0, 1, At, B1); PG8_BAR; PG8_SCHED;
            PG8_LDA(At, 0, 1); PG8_STAGE(PG8_SB(0, 0), b2, voffB); PG8_STAGE(PG8_SB(0, 1), b2 + hstepB, voffB); PG8_STAGE(PG8_SA(0, 0), a2, voffA);
            PG8_WAIT_V(8); PG8_WAIT_L(0); PG8_BAR; PG8_MMA(1, 0, At, B0); PG8_MMA(1, 1, At, B1); PG8_BAR; PG8_SCHED;
            PG8_LDB(B0, 1, 0); PG8_LDB(B1, 1, 1); PG8_SCHED; PG8_LDA(At, 1, 0); PG8_STAGE(PG8_SA(0, 1), a2 + hstepA, voffA);
            PG8_WAIT_V(8); PG8_WAIT_L(0); PG8_BAR; PG8_MMA(0, 0, At, B0); PG8_MMA(0, 1, At, B1); PG8_BAR; PG8_SCHED;
            PG8_LDA(At, 1, 1); PG8_STAGE(PG8_SB(1, 0), b3, voffB); PG8_STAGE(PG8_SB(1, 1), b3 + hstepB, voffB); PG8_STAGE(PG8_SA(1, 0), a3, voffA);
            PG8_WAIT_V(8); PG8_WAIT_L(0); PG8_BAR; PG8_MMA(1, 0, At, B0); PG8_MMA(1, 1, At, B1); PG8_BAR; PG8_SCHED;
        }
        if constexpr (ALIGN_EPI) { if (wr == 0) PG8_BAR; }
        E(acc, cur, wr, wc, fr, fq, (const LAS float*)(rsb + (ui & 1) * 1024)); S.done(cur);
        if constexpr (Epi::USES_RS) { if (has_next) PG8_RS_STAGE(nxt.pm, (ui + 1) & 1); }
        if (!has_next) break;
#pragma unroll
        for (int a = 0; a < 2; ++a)
#pragma unroll
            for (int b = 0; b < 2; ++b)
#pragma unroll
                for (int m = 0; m < 4; ++m)
#pragma unroll
                    for (int n = 0; n < 2; ++n) acc[a][b][m][n] = (f32x4){0.f, 0.f, 0.f, 0.f};
        cur = nxt; cA = nA; cB = nB; ++ui;
        if constexpr (ALIGN_EPI) { if (wr == 1) PG8_BAR; }
    }
    PG8_WAIT_V(0);
    if constexpr (!ALIGN_EPI) { if (wr == 0) PG8_BAR; }
    PG8_BAR;
#undef PG8_RS_STAGE
#undef PG8_SA
#undef PG8_SB
#undef PG8_STAGE
#undef PG8_LDA
#undef PG8_LDB
#undef PG8_MMA
#undef PG8_WAIT_V
#undef PG8_WAIT_L
#undef PG8_BAR
#undef PG8_SCHED
}
}

#define XB_TMO      128
#define XB_XCNT(j)  (256  + 64 * (j))
#define XB_XSUB(j)  (1280 + 64 * (j))
#define XB_XGEN(j)  (2304 + 64 * (j))
#define XB_TOP      3328
#define XB_TOPGEN   3392
#define XCD_BAR_WORDS 3456
#define XB_SPIN_CAP (1u << 18)
__device__ __forceinline__ unsigned xb_ld(unsigned* p)              { return __hip_atomic_load(p, __ATOMIC_RELAXED, __HIP_MEMORY_SCOPE_AGENT); }
__device__ __forceinline__ unsigned xb_add(unsigned* p, unsigned v) { return __hip_atomic_fetch_add(p, v, __ATOMIC_RELAXED, __HIP_MEMORY_SCOPE_AGENT); }
__device__ __forceinline__ unsigned xb_xcc_id() { return (unsigned)__builtin_amdgcn_s_getreg((3 << 11) | 20) & 0xFu; }
#define XB_SPIN(cond, bar) do { unsigned _sp = 0; while (cond) { __builtin_amdgcn_s_sleep(1); \
    if ((++_sp & 255u) == 0u) { if (xb_ld(&(bar)[XB_TMO])) break; if (_sp > XB_SPIN_CAP) { atomicAdd(&(bar)[XB_TMO], 1u); break; } } } } while (0)
struct XcdBarrier { unsigned* bar; unsigned x; volatile LAS unsigned* st; };
__device__ __forceinline__ XcdBarrier xcd_barrier_post(unsigned* bar, volatile LAS unsigned* st) {
    XcdBarrier b; b.bar = bar; b.x = xb_xcc_id(); b.st = st;
    if (threadIdx.x == 0) (void)xb_add(&bar[XB_XCNT(b.x)], 1u);
    return b;
}
__device__ __forceinline__ void xcd_barrier_complete(unsigned* bar, unsigned x, unsigned& nloc, unsigned& nx) {
    const unsigned G = gridDim.x * gridDim.y * gridDim.z;
    unsigned sum, cnt, mine, sp = 0u;
    for (;;) {
        sum = 0u; cnt = 0u; mine = 0u;
#pragma unroll
        for (unsigned j = 0; j < 16; ++j) { const unsigned c = xb_ld(&bar[XB_XCNT(j)]); sum += c; cnt += (c > 0u) ? 1u : 0u; mine = (j == x) ? c : mine; }
        if (sum == G) break;
        __builtin_amdgcn_s_sleep(1);
        if ((++sp & 255u) == 0u) { if (xb_ld(&bar[XB_TMO])) break; if (sp > XB_SPIN_CAP) { atomicAdd(&bar[XB_TMO], 1u); break; } }
    }
    nloc = mine > 0u ? mine : 1u; nx = cnt > 0u ? cnt : 1u;
}
__device__ __forceinline__ void xcd_barrier(const XcdBarrier& b) {
    asm volatile("s_waitcnt vmcnt(0)" ::: "memory");
    __syncthreads();
    if (threadIdx.x == 0) {
        unsigned* bar = b.bar;
        __builtin_amdgcn_s_waitcnt(0);
        unsigned nloc = b.st[0], nx = b.st[1];
        if (nloc == 0u) { xcd_barrier_complete(bar, b.x, nloc, nx); b.st[0] = nloc; b.st[1] = nx; }
        const unsigned old = xb_add(&bar[XB_XSUB(b.x)], 1u);
        const unsigned gen = old / nloc;
        if (old + 1u == (gen + 1u) * nloc) {
            __builtin_amdgcn_fence(__ATOMIC_RELEASE, "agent");
            asm volatile("s_waitcnt vmcnt(0)" ::: "memory");
            const unsigned og = xb_add(&bar[XB_TOP], 1u);
            const unsigned tg = og / nx;
            if (og + 1u == (tg + 1u) * nx) xb_add(&bar[XB_TOPGEN], 1u);
            else XB_SPIN(xb_ld(&bar[XB_TOPGEN]) == tg, bar);
            __builtin_amdgcn_fence(__ATOMIC_ACQUIRE, "agent");
            xb_add(&bar[XB_XGEN(b.x)], 1u);
            asm volatile("s_waitcnt vmcnt(0)" ::: "memory");
        } else {
            XB_SPIN(xb_ld(&bar[XB_XGEN(b.x)]) == gen, bar);
            __builtin_amdgcn_fence(__ATOMIC_ACQUIRE, "agent");
            asm volatile("s_waitcnt vmcnt(0)" ::: "memory");
        }
    }
    __syncthreads();
}

struct Args {
    const float* in[15]; float* out; unsigned char* ws;
    float inv[8];
    int ph_lo, ph_hi, li, pad;
};
typedef const Args __attribute__((address_space(4))) KArgs;
__device__ __forceinline__ KArgs* fresh_ka() { KArgs* p = (KArgs*)__builtin_amdgcn_kernarg_segment_ptr(); asm volatile("" : "+s"(p)); return p; }
struct Frame {
    LAS unsigned char* lds;
    int lane, wave, G, gw, NGW, vcu;
    KArgs* ka;
    __device__ __forceinline__ const float* x_prompt() const { return ka->in[0]; }
    __device__ __forceinline__ const float* x_sample() const { return ka->in[1]; }
    __device__ __forceinline__ const float* g_mix_pre() const { return ka->in[2]; }
    __device__ __forceinline__ const float* g_mix_post() const { return ka->in[3]; }
    __device__ __forceinline__ const float* g_ffn_pre() const { return ka->in[4]; }
    __device__ __forceinline__ const float* g_ffn_post() const { return ka->in[5]; }
    __device__ __forceinline__ const float* w_in_ab() const { return ka->in[6]; }
    __device__ __forceinline__ const float* w_out_ab() const { return ka->in[7]; }
    __device__ __forceinline__ const float* rpb_a() const { return ka->in[8]; }
    __device__ __forceinline__ const float* sink_b() const { return ka->in[9]; }
    __device__ __forceinline__ const float* w_in_c() const { return ka->in[10]; }
    __device__ __forceinline__ const float* w_out_c() const { return ka->in[11]; }
    __device__ __forceinline__ const float* w_gate() const { return ka->in[12]; }
    __device__ __forceinline__ const float* w_up() const { return ka->in[13]; }
    __device__ __forceinline__ const float* w_down() const { return ka->in[14]; }
    __device__ __forceinline__ float* x() const { return ka->out; }
    __device__ __forceinline__ float* rope() const { return (float*)(ka->ws + WS_ROPE); }
    __device__ __forceinline__ float* rstd() const { return (float*)(ka->ws + WS_RSTD); }
    __device__ __forceinline__ float* lse() const { return (float*)(ka->ws + WS_LSE); }
    __device__ __forceinline__ bf16_t* WIN() const { return (bf16_t*)(ka->ws + WS_WIN); }
    __device__ __forceinline__ bf16_t* WOUT() const { return (bf16_t*)(ka->ws + WS_WOUT); }
    __device__ __forceinline__ bf16_t* WGU() const { return (bf16_t*)(ka->ws + WS_WGU); }
    __device__ __forceinline__ bf16_t* WD() const { return (bf16_t*)(ka->ws + WS_WD); }
    __device__ __forceinline__ bf16_t* XB() const { return (bf16_t*)(ka->ws + WS_XB); }
    __device__ __forceinline__ bf16_t* BIG() const { return (bf16_t*)(ka->ws + WS_BIG); }
};

__device__ __forceinline__ int ropeperm(int x) { const int d = x & 63; return (x & ~63) + ((d >= 4 && d < 8) ? d + 4 : (d >= 8 && d < 12) ? d - 4 : d); }
__device__ __forceinline__ void conv_map(int kind, int n, int& row, float& cs) {
    cs = 1.f; row = n;
    if (kind == 0) {
        if (n < 1024) { row = n; cs = QSCALE; }
        else if (n < 2048) row = 2048 + (n - 1024);
        else if (n < 3072) row = 3072 + (n - 2048);
        else if (n < 4096) { row = 1024 + ropeperm(n - 3072); cs = QSCALE; }
        else if (n < 4352) row = 4096 + ropeperm(n - 4096);
        else row = n;
    } else if (kind == 1) {
        const int gi = n / 3072, r = n % 3072, qkv = r >> 10, xx = r & 1023;
        row = (qkv * 3 + gi) * 1024 + (qkv < 2 ? ropeperm(xx) : xx); if (qkv == 0) cs = QSCALE;
    } else if (kind == 3) row = (n >> 7) * 256 + (n & 127);
    else if (kind == 4) row = (n >> 7) * 256 + 128 + (n & 127);
}
__device__ __forceinline__ void conv_item(const float* W, int K, int N, bf16_t* WT, int NR, const float* gain, int kind, LAS unsigned char* scr, int item, int lane) {
    const int nblk = N / 64, kb = item / nblk, nb = item % nblk, k0 = 64 * kb, n0 = 64 * nb;
    const int kq = lane >> 4, nq = 4 * (lane & 15);
    f32x4 v[16]; float gk[16];
#pragma unroll
    for (int i = 0; i < 16; ++i) v[i] = *(const f32x4*)(W + (size_t)(k0 + 4 * i + kq) * N + n0 + nq);
#pragma unroll
    for (int i = 0; i < 16; ++i) gk[i] = gain ? gain[k0 + 4 * i + kq] : 1.f;
    float cs[4];
#pragma unroll
    for (int e = 0; e < 4; ++e) { int row; conv_map(kind, n0 + nq + e, row, cs[e]); }
#pragma unroll
    for (int i = 0; i < 16; ++i) { u32x2 w; w.x = pk2(v[i][0] * gk[i] * cs[0], v[i][1] * gk[i] * cs[1]); w.y = pk2(v[i][2] * gk[i] * cs[2], v[i][3] * gk[i] * cs[3]);
        *(LAS u32x2*)(scr + (4 * i + kq) * 136 + 2 * nq) = w; }
    asm volatile("s_waitcnt lgkmcnt(0)" ::: "memory");
    const int c = lane & 7;
#pragma unroll
    for (int j = 0; j < 8; ++j) { const int n = (lane >> 3) + 8 * j; const LAS unsigned short* sp = (const LAS unsigned short*)(scr + (8 * c) * 136 + 2 * n);
        int row; float csd; conv_map(kind, n0 + n, row, csd);
        u32x4 o; o.x = (unsigned)sp[0] | ((unsigned)sp[68] << 16); o.y = (unsigned)sp[2 * 68] | ((unsigned)sp[3 * 68] << 16);
        o.z = (unsigned)sp[4 * 68] | ((unsigned)sp[5 * 68] << 16); o.w = (unsigned)sp[6 * 68] | ((unsigned)sp[7 * 68] << 16);
        *(u32x4*)(WT + ((size_t)kb * NR + row) * 64 + 8 * c) = o; }
    asm volatile("s_waitcnt lgkmcnt(0)" ::: "memory");
}
__device__ __forceinline__ void convert_layer_weights(Frame& F, int layer) {
    LAS unsigned char* scr = F.lds + RING_OFF + F.wave * 16384;
    const int i = layer >> 1; const bool even = (layer & 1) == 0;
    const int n_in = even ? N_AB : N_C, k_out = even ? 2048 : 1024;
    const int I_IN = (D / 64) * (n_in / 64), I_OUT = (k_out / 64) * (D / 64), I_G = (D / 64) * (FF / 64), I_D = (FF / 64) * (D / 64);
    const int total = I_IN + I_OUT + 2 * I_G + I_D;
    const float* w_in = even ? F.w_in_ab() + (size_t)i * D * N_AB : F.w_in_c() + (size_t)i * D * N_C;
    const float* w_out = even ? F.w_out_ab() + (size_t)i * 2048 * D : F.w_out_c() + (size_t)i * 1024 * D;
    for (int it = F.gw; it < total; it += F.NGW) {
        int r = it;
        if (r < I_IN) { conv_item(w_in, D, n_in, F.WIN(), n_in, F.g_mix_pre() + layer * D, even ? 0 : 1, scr, r, F.lane); continue; } r -= I_IN;
        if (r < I_OUT) { conv_item(w_out, k_out, D, F.WOUT(), D, nullptr, 2, scr, r, F.lane); continue; } r -= I_OUT;
        if (r < I_G) { conv_item(F.w_gate() + (size_t)layer * D * FF, D, FF, F.WGU(), N_GU, F.g_ffn_pre() + layer * D, 3, scr, r, F.lane); continue; } r -= I_G;
        if (r < I_G) { conv_item(F.w_up() + (size_t)layer * D * FF, D, FF, F.WGU(), N_GU, F.g_ffn_pre() + layer * D, 4, scr, r, F.lane); continue; } r -= I_G;
        conv_item(F.w_down() + (size_t)layer * FF * D, FF, D, F.WD(), D, nullptr, 2, scr, r, F.lane);
    }
}

__device__ __forceinline__ void prologue_rows(Frame& F) {
    for (int row = F.gw; row < T; row += F.NGW) {
        const float* src = row < 8 * SEQ ? F.x_prompt() + (size_t)row * D : F.x_sample() + (size_t)(row - 8 * SEQ) * D;
        float ss = 0.f;
#pragma unroll
        for (int j = 0; j < 4; ++j) { const int c = 8 * F.lane + 512 * j;
            const f32x4 a = *(const f32x4*)(src + c), b = *(const f32x4*)(src + c + 4);
            ss += (a[0] * a[0] + a[1] * a[1]) + (a[2] * a[2] + a[3] * a[3]) + (b[0] * b[0] + b[1] * b[1]) + (b[2] * b[2] + b[3] * b[3]);
            u32x4 w; w.x = pk2(a[0], a[1]); w.y = pk2(a[2], a[3]); w.z = pk2(b[0], b[1]); w.w = pk2(b[2], b[3]);
            *(u32x4*)(F.XB() + ((size_t)((F.lane >> 3) + 8 * j) * T + row) * 64 + 8 * (F.lane & 7)) = w; }
        ss = wave_sum(ss);
        if (F.lane == 0) F.rstd()[row] = 1.0f / sqrtf(ss * (1.0f / D) + RMS_EPS);
    }
}
template <bool FINAL, bool DUMMY> __device__ __forceinline__ void residual_rows(Frame& F, const bf16_t* mptr, int mpitch, const float* gain) {
    bf16_t* xbout = DUMMY ? (bf16_t*)F.x() : F.XB(); float* rsout = DUMMY ? F.lse() : F.rstd();
    for (int row = F.gw; row < T; row += F.NGW) {
        float mv[4][8]; float ss = 0.f;
#pragma unroll
        for (int j = 0; j < 4; ++j) { const int c = 8 * F.lane + 512 * j; const u32x4 w = *(const u32x4*)(mptr + (size_t)row * mpitch + c);
            mv[j][0] = bflo(w.x); mv[j][1] = bfhi(w.x); mv[j][2] = bflo(w.y); mv[j][3] = bfhi(w.y); mv[j][4] = bflo(w.z); mv[j][5] = bfhi(w.z); mv[j][6] = bflo(w.w); mv[j][7] = bfhi(w.w);
#pragma unroll
            for (int e = 0; e < 8; ++e) ss += mv[j][e] * mv[j][e]; }
        ss = wave_sum(ss);
        const float rs = 1.0f / sqrtf(ss * (1.0f / D) + RMS_EPS);
        float s2 = 0.f;
#pragma unroll
        for (int j = 0; j < 4; ++j) { const int c = 8 * F.lane + 512 * j;
            const size_t xo = ((size_t)((F.lane >> 3) + 8 * j) * T + row) * 64 + 8 * (F.lane & 7);
            const u32x4 xw = *(const u32x4*)(F.XB() + xo);
            const f32x4 a = (f32x4){bflo(xw.x), bfhi(xw.x), bflo(xw.y), bfhi(xw.y)}, b = (f32x4){bflo(xw.z), bfhi(xw.z), bflo(xw.w), bfhi(xw.w)};
            const f32x4 ga = *(const f32x4*)(gain + c), gb = *(const f32x4*)(gain + c + 4);
            f32x4 na, nb;
#pragma unroll
            for (int e = 0; e < 4; ++e) { na[e] = a[e] + mv[j][e] * rs * ga[e]; nb[e] = b[e] + mv[j][4 + e] * rs * gb[e]; }
            if (FINAL) { float* xo = F.x() + (size_t)row * D + c; *(f32x4*)xo = na; *(f32x4*)(xo + 4) = nb; }
            else {
                s2 += (na[0] * na[0] + na[1] * na[1]) + (na[2] * na[2] + na[3] * na[3]) + (nb[0] * nb[0] + nb[1] * nb[1]) + (nb[2] * nb[2] + nb[3] * nb[3]);
                u32x4 w; w.x = pk2(na[0], na[1]); w.y = pk2(na[2], na[3]); w.z = pk2(nb[0], nb[1]); w.w = pk2(nb[2], nb[3]);
                *(u32x4*)(xbout + xo) = w; } }
        if (!FINAL) { s2 = wave_sum(s2); if (F.lane == 0) rsout[row] = 1.0f / sqrtf(s2 * (1.0f / D) + RMS_EPS); }
    }
}

constexpr float ATT_NEG = -1e30f, ATT_FLOOR = -30000.f;
__device__ __forceinline__ void att_dma(LAS unsigned char* ring, const bf16_t* kbase, const bf16_t* vbase, long row0, int cstep, int jstride, int nch, unsigned vmask, int wave, int lane) {
    int j, ldsoff; const bf16_t* b0;
    if (wave < 4) { j = lane & 31; b0 = kbase + (2 * wave + (lane >> 5)) * 8; ldsoff = wave * 1024; }
    else { const int i = wave - 4; j = 16 * (i & 1) + (lane >> 2); b0 = vbase + 32 * (i >> 1) + 8 * (lane & 3); ldsoff = 4096 + (i >> 1) * 2048 + (i & 1) * 1024; }
    const bf16_t* p0 = b0 + (row0 + (long)j * jstride) * 64;
    for (int c = 0; c < nch; ++c)
        if ((vmask >> c) & 1u) __builtin_amdgcn_global_load_lds((const unsigned*)(p0 + (long)c * cstep * 64), (LAS unsigned*)(ring + c * 8192 + ldsoff), 16, 0, 0);
}
__device__ __forceinline__ f32x16 att_qk(const LAS unsigned char* Kc, const bf16x8 (&qr)[4], const f32x16& negm, int l31, int hi) {
    f32x16 s = negm;
#pragma unroll
    for (int d0 = 0; d0 < 4; ++d0) { const bf16x8 kf = *(const LAS bf16x8*)(Kc + (2 * d0 + hi) * 512 + l31 * 16); s = __builtin_amdgcn_mfma_f32_32x32x16_bf16(kf, qr[d0], s, 0, 0, 0); }
    return s;
}
__device__ __forceinline__ s16x4 att_vtr(const LAS unsigned char* p) { return __builtin_bit_cast(s16x4, __builtin_amdgcn_ds_read_tr16_b64_v4i16((LAS s16x4*)p)); }
constexpr float ATT_THR = 8.f;
__device__ __forceinline__ void att_softmax_pv(f32x16& s, const LAS unsigned char* Vc, float& m, f32x16& negm, float& l, f32x16& o0, f32x16& o1, bool first, int lane) {
    const int hi = lane >> 5;
    float cm = fmaxf(fmaxf(s[0], s[1]), fmaxf(s[2], s[3]));
#pragma unroll
    for (int r = 4; r < 16; r += 4) cm = fmaxf(cm, fmaxf(fmaxf(s[r], s[r + 1]), fmaxf(s[r + 2], s[r + 3])));
    { auto rr = __builtin_amdgcn_permlane32_swap(__float_as_uint(cm), __float_as_uint(cm), false, false); cm = fmaxf(__uint_as_float(rr[0]), __uint_as_float(rr[1])); }
    if (first || __any(cm > ATT_THR)) {
        const float dl = first ? fmaxf(cm, ATT_FLOOR) : fmaxf(cm, 0.f), alpha = first ? 0.f : __builtin_amdgcn_exp2f(-dl);
        m += dl; l *= alpha;
#pragma unroll
        for (int r = 0; r < 16; ++r) { s[r] -= dl; o0[r] *= alpha; o1[r] *= alpha; negm[r] = -m; }
    }
    float ps = 0.f;
#pragma unroll
    for (int r = 0; r < 16; ++r) { s[r] = __builtin_amdgcn_exp2f(s[r]); ps += s[r]; }
    l += ps;
    u32x4 pw0, pw1;
    pw0.x = cvt_pk_bf16(s[0], s[1]); pw0.y = cvt_pk_bf16(s[2], s[3]); pw0.z = cvt_pk_bf16(s[4], s[5]); pw0.w = cvt_pk_bf16(s[6], s[7]);
    pw1.x = cvt_pk_bf16(s[8], s[9]); pw1.y = cvt_pk_bf16(s[10], s[11]); pw1.z = cvt_pk_bf16(s[12], s[13]); pw1.w = cvt_pk_bf16(s[14], s[15]);
    const bf16x8 pb0 = __builtin_bit_cast(bf16x8, pw0), pb1 = __builtin_bit_cast(bf16x8, pw1);
    const LAS unsigned char* vb = Vc + (4 * hi + ((lane & 15) >> 2)) * 64 + ((lane >> 4) & 1) * 32 + (lane & 3) * 8;
#pragma unroll
    for (int d0 = 0; d0 < 2; ++d0) {
        const s16x4 a0 = att_vtr(vb + d0 * 2048), a1 = att_vtr(vb + d0 * 2048 + 512), b0 = att_vtr(vb + d0 * 2048 + 1024), b1 = att_vtr(vb + d0 * 2048 + 1536);
        const bf16x8 vf0 = (bf16x8){a0[0], a0[1], a0[2], a0[3], a1[0], a1[1], a1[2], a1[3]}, vf1 = (bf16x8){b0[0], b0[1], b0[2], b0[3], b1[0], b1[1], b1[2], b1[3]};
        if (d0 == 0) { o0 = __builtin_amdgcn_mfma_f32_32x32x16_bf16(vf0, pb0, o0, 0, 0, 0); o0 = __builtin_amdgcn_mfma_f32_32x32x16_bf16(vf1, pb1, o0, 0, 0, 0); }
        else { o1 = __builtin_amdgcn_mfma_f32_32x32x16_bf16(vf0, pb0, o1, 0, 0, 0); o1 = __builtin_amdgcn_mfma_f32_32x32x16_bf16(vf1, pb1, o1, 0, 0, 0); }
    }
}
__device__ __forceinline__ float att_half_sum(float v) { auto rr = __builtin_amdgcn_permlane32_swap(__float_as_uint(v), __float_as_uint(v), false, false); return __uint_as_float(rr[0]) + __uint_as_float(rr[1]); }
__device__ __forceinline__ void att_load_q(bf16x8 (&qr)[4], const bf16_t* qp  , int hi) {
#pragma unroll
    for (int d0 = 0; d0 < 4; ++d0) qr[d0] = *(const bf16x8*)(qp + 16 * d0 + 8 * hi);
}
__device__ __forceinline__ void att_store_o(bf16_t* op, const f32x16& o0, const f32x16& o1, float f, int hi) {
#pragma unroll
    for (int g = 0; g < 4; ++g) {
        u32x2 w0, w1; w0.x = cvt_pk_bf16(o0[4 * g] * f, o0[4 * g + 1] * f); w0.y = cvt_pk_bf16(o0[4 * g + 2] * f, o0[4 * g + 3] * f);
        w1.x = cvt_pk_bf16(o1[4 * g] * f, o1[4 * g + 1] * f); w1.y = cvt_pk_bf16(o1[4 * g + 2] * f, o1[4 * g + 3] * f);
        *(u32x2*)(op + 8 * g + 4 * hi) = w0; *(u32x2*)(op + 32 + 8 * g + 4 * hi) = w1; }
}
__device__ __forceinline__ void att_tri_mask(f32x16& s, int edge, int dq  ) {
#pragma unroll
    for (int r = 0; r < 16; ++r) { const int jj = (r & 3) + 8 * (r >> 2) + dq; const bool ok = edge < 0 ? (jj >= 0) : (jj <= 0); s[r] = ok ? s[r] : ATT_NEG; }
}

template <bool DUMMY> __device__ __forceinline__ void mfma_attn_b(Frame& F, int li) {
    LAS unsigned char* ring = F.lds + RING_OFF;
    const int lane = F.lane, l31 = lane & 31, hi = lane >> 5, wave = F.wave;
    for (int u = F.vcu; u < NSEQ * 4 * 64; u += F.G) {
        const int blk = u & 63, kvh = (u >> 6) & 3, b = u >> 8, t0 = blk * 64, sb = b * SEQ;
        unsigned vmask = 0u;
        for (int c = 0; c < 10; ++c) { const int kt = t0 - 128 + 32 * c; if (kt >= 0 && kt < SEQ) vmask |= 1u << c; }
        att_dma(ring, F.BIG() + (64 + kvh) * (size_t)T * 64, F.BIG() + (68 + kvh) * (size_t)T * 64, (long)sb + t0 - 128, 32, 1, 10, vmask, wave, lane);
        const int qt = wave & 1, head = kvh * 4 + (wave >> 1);
        const size_t qoff = ((size_t)(16 + head) * T + (sb + t0 + 32 * qt + l31)) * 64; bf16_t* qp = F.BIG() + qoff;
        bf16x8 qr[4]; att_load_q(qr, qp, hi);
        asm volatile("s_waitcnt vmcnt(0)" ::: "memory"); __syncthreads();
        float m = F.sink_b()[li * 16 + head] * LOG2E, l = hi == 0 ? 1.f : 0.f;
        f32x16 o0, o1, negm;
#pragma unroll
        for (int r = 0; r < 16; ++r) { o0[r] = 0.f; o1[r] = 0.f; negm[r] = -m; }
        for (int c = qt; c <= qt + 8; ++c) {
            if (!((vmask >> c) & 1u)) continue;
            f32x16 s = att_qk(ring + c * 8192, qr, negm, l31, hi);
            const int rel = c - qt - 4;
            if (rel == -4) att_tri_mask(s, -1, 4 * hi - l31); else if (rel == 4) att_tri_mask(s, 1, 4 * hi - l31);
            att_softmax_pv(s, ring + c * 8192 + 4096, m, negm, l, o0, o1, false, lane);
        }
        const float lt = att_half_sum(l);
        att_store_o(DUMMY ? (bf16_t*)F.x() + qoff : qp, o0, o1, 1.0f / lt, hi);
        __syncthreads();
    }
}
template <bool DUMMY> __device__ __forceinline__ void mfma_attn_a(Frame& F, int li) {
    LAS unsigned char* ring = F.lds + RING_OFF;
    LAS float* biasT = (LAS float*)(F.lds + BIAS_OFF);
    const int lane = F.lane, l31 = lane & 31, hi = lane >> 5, wave = F.wave;
    for (int u = F.vcu; u < NSEQ * 16 * 32; u += F.G) {
        const int C4 = u & 3, R = (u >> 2) & 7, h = (u >> 5) & 15, b = u >> 9, sb = b * SEQ;
        const int kr0 = min(max(8 * R - 4, 0), 56), krl = min(max(8 * R + 3, 0), 56) + 7, nch = krl - kr0 + 1;
        const int kc0 = min(max(16 * C4 - 8, 0), 32);
        att_dma(ring, F.BIG() + (32 + h) * (size_t)T * 64, F.BIG() + (48 + h) * (size_t)T * 64, (long)sb + kr0 * 64 + kc0, 64, 1, nch, 0xffffu, wave, lane);
        for (int i = wave * 64 + lane; i < 465; i += NWAVES * 64) biasT[i] = F.rpb_a()[(size_t)(li * 16 + h) * 465 + i] * LOG2E;
        const int wq = wave & 3;
        const int qrow_g = 8 * R + 2 * wq + (l31 >> 4), qcol_g = 16 * C4 + (l31 & 15);
        const size_t qoff = ((size_t)h * T + (sb + qrow_g * 64 + qcol_g)) * 64; bf16_t* qp = F.BIG() + qoff;
        bf16x8 qr[4]; att_load_q(qr, qp, hi);
        asm volatile("s_waitcnt vmcnt(0)" ::: "memory"); __syncthreads();
        if (wave < 4) {
            const int rs_l = min(max(qrow_g - 4, 0), 56), cs_l = min(max(qcol_g - 8, 0), 48);
            const int jb_l = 4 * hi - (cs_l - kc0), bbase_l = kc0 - qcol_g + 15 + 4 * hi;
            const int c_lo = min(max(8 * R + 2 * wq - 4, 0), 56) - kr0, c_hi = min(max(8 * R + 2 * wq + 1 - 4, 0), 56) + 7 - kr0;
            float m = 0.f, l = 0.f;
            f32x16 o0, o1, negm;
#pragma unroll
            for (int r = 0; r < 16; ++r) { o0[r] = 0.f; o1[r] = 0.f; negm[r] = 0.f; }
            for (int ci = c_lo; ci <= c_hi; ++ci) {
                const int c = ci == c_lo ? c_lo + 1 : ci == c_lo + 1 ? c_lo : ci;
                f32x16 s = att_qk(ring + c * 8192, qr, negm, l31, hi);
                const int kr = kr0 + c; const bool rowok = (kr >= rs_l) && (kr < rs_l + 8);
                const int bo = (kr - qrow_g + 7) * 31 + bbase_l;
                float bv[16];
#pragma unroll
                for (int r = 0; r < 16; ++r) bv[r] = biasT[min(max(bo + (r & 3) + 8 * (r >> 2), 0), 464)];
#pragma unroll
                for (int r = 0; r < 16; ++r) { const int jj = (r & 3) + 8 * (r >> 2); const bool ok = rowok && ((unsigned)(jj + jb_l) < 16u); s[r] = ok ? s[r] + bv[r] : ATT_NEG; }
                att_softmax_pv(s, ring + c * 8192 + 4096, m, negm, l, o0, o1, ci == c_lo, lane);
            }
            const float lt = att_half_sum(l);
            att_store_o(DUMMY ? (bf16_t*)F.x() + qoff : qp, o0, o1, 1.0f / lt, hi);
        }
        __syncthreads();
    }
}
template <int PASS, bool DUMMY> __device__ __forceinline__ void mfma_attn_c(Frame& F) {
    LAS unsigned char* ring = F.lds + RING_OFF;
    const int lane = F.lane, l31 = lane & 31, hi = lane >> 5, wave = F.wave;
    const int nunits = PASS == 1 ? 2 * 2560 : 2560;
    for (int u = F.vcu; u < nunits; u += F.G) {
        const int g = PASS == 1 ? 1 + u / 2560 : 0, v = u % 2560, b = v >> 8, h = (v >> 4) & 15, sub = v & 15;
        const int d = g == 0 ? 1 : g == 1 ? 4 : 16, lm = SEQ / d, res = sub % d, m0 = 256 * (sub / d), sb = b * SEQ;
        unsigned vmask = 0u;
        for (int c = 0; c < 12; ++c) { const int p = m0 - 64 + 32 * c; if (p >= 0 && p < lm) vmask |= 1u << c; }
        att_dma(ring, F.BIG() + (48 + g * 16 + h) * (size_t)T * 64, F.BIG() + (96 + g * 16 + h) * (size_t)T * 64, (long)sb + (long)(m0 - 64) * d + res, 32 * d, d, 12, vmask, wave, lane);
        const size_t qrow = (size_t)(sb + (m0 + 32 * wave + l31) * d + res);
        const size_t qoff = ((size_t)(g * 16 + h) * T + qrow) * 64; bf16_t* qp = F.BIG() + qoff;
        bf16x8 qr[4]; att_load_q(qr, qp, hi);
        asm volatile("s_waitcnt vmcnt(0)" ::: "memory"); __syncthreads();
        float m = 0.f, l = 0.f; bool first = true;
        f32x16 o0, o1, negm;
#pragma unroll
        for (int r = 0; r < 16; ++r) { o0[r] = 0.f; o1[r] = 0.f; negm[r] = 0.f; }
        for (int c = wave; c <= wave + 4; ++c) {
            if (!((vmask >> c) & 1u)) continue;
            f32x16 s = att_qk(ring + c * 8192, qr, negm, l31, hi);
            const int rel = c - wave - 2;
            if (rel == -2) att_tri_mask(s, -1, 4 * hi - l31); else if (rel == 2) att_tri_mask(s, 1, 4 * hi - l31);
            att_softmax_pv(s, ring + c * 8192 + 4096, m, negm, l, o0, o1, first, lane); first = false;
        }
        const float lt = att_half_sum(l);
        const float L = m + __builtin_amdgcn_logf(lt);
        if (PASS == 1) {
            att_store_o(DUMMY ? (bf16_t*)F.x() + qoff : qp, o0, o1, 1.0f / lt, hi);
            if (hi == 0) F.lse()[((size_t)(g - 1) * T + qrow) * 16 + h] = L;
        } else {
            const float L1 = F.lse()[(qrow) * 16 + h], L2 = F.lse()[((size_t)T + qrow) * 16 + h];
            const float Lm = fmaxf(L, fmaxf(L1, L2));
            const float w0 = __builtin_amdgcn_exp2f(L - Lm), w1 = __builtin_amdgcn_exp2f(L1 - Lm), w2 = __builtin_amdgcn_exp2f(L2 - Lm), iw = 1.0f / (w0 + w1 + w2);
            const float f0 = w0 * iw / lt, f1 = w1 * iw, f2 = w2 * iw;
            const bf16_t* p1 = qp + 16 * (size_t)T * 64; const bf16_t* p2 = qp + 32 * (size_t)T * 64;
#pragma unroll
            for (int g4 = 0; g4 < 4; ++g4)
#pragma unroll
                for (int d0 = 0; d0 < 2; ++d0) {
                    const u32x2 a = *(const u32x2*)(p1 + 32 * d0 + 8 * g4 + 4 * hi), c2 = *(const u32x2*)(p2 + 32 * d0 + 8 * g4 + 4 * hi);
                    const f32x16& o = d0 == 0 ? o0 : o1;
                    const float r0 = o[4 * g4] * f0 + bflo(a.x) * f1 + bflo(c2.x) * f2, r1 = o[4 * g4 + 1] * f0 + bfhi(a.x) * f1 + bfhi(c2.x) * f2;
                    const float r2 = o[4 * g4 + 2] * f0 + bflo(a.y) * f1 + bflo(c2.y) * f2, r3 = o[4 * g4 + 3] * f0 + bfhi(a.y) * f1 + bfhi(c2.y) * f2;
                    u32x2 w; w.x = cvt_pk_bf16(r0, r1); w.y = cvt_pk_bf16(r2, r3);
                    *(u32x2*)((DUMMY ? (bf16_t*)F.x() + qoff : qp) + 32 * d0 + 8 * g4 + 4 * hi) = w; }
        }
        __syncthreads();
    }
}

constexpr int NPH = 1 + DEPTH * 8;
__global__ void __launch_bounds__(NWAVES * 64, 2) fwd(Args args) {
    extern __shared__ __attribute__((aligned(16))) unsigned char lds[];
    Frame F;
    F.lds = (LAS unsigned char*)lds;
    F.wave = __builtin_amdgcn_readfirstlane((int)threadIdx.x >> 6); F.lane = fresh_lane(); F.ka = fresh_ka();
    F.G = gridDim.x; F.gw = blockIdx.x * NWAVES + F.wave; F.NGW = F.G * NWAVES;
    F.vcu = (F.G % 8 == 0) ? (int)(blockIdx.x % 8) * (F.G / 8) + (int)(blockIdx.x / 8) : (int)blockIdx.x;
    F.ka = fresh_ka();
    unsigned char* ws = args.ws;
    volatile LAS unsigned* MISC = (volatile LAS unsigned*)(F.lds + MISC_OFF);
    for (int u = F.wave * 64 + F.lane; u < (LDS_BYTES - LDSCTL_OFF) / 4; u += NWAVES * 64) ((LAS unsigned*)(F.lds + LDSCTL_OFF))[u] = 0u;
    __syncthreads();
    unsigned* barw = (unsigned*)(ws + WS_CTL) + CW_BAR;
    XcdBarrier bar; bar.bar = barw; bar.x = 0; bar.st = nullptr;
    if (!MK_PER_PHASE) bar = xcd_barrier_post(barw, MISC + 8);
    const int lo = args.ph_lo, hi = args.ph_hi;
#define IN(k) (lo <= (k) && (k) < hi)
#define SEAM(k) do { if (!MK_PER_PHASE) { if (IN(k) && IN((k) + 1)) xcd_barrier(bar); } } while (0)

    if (IN(0)) {
        F.lane = fresh_lane(); F.ka = fresh_ka();
        prologue_rows(F);
        for (int rep = 0; rep < (PROBE == 4 ? 2 : 1); ++rep) convert_layer_weights(F, 0);
    }
    SEAM(0);
    for (int layer = 0; layer < DEPTH; ++layer) {
        const int pb = 1 + 8 * layer; const bool even = (layer & 1) == 0; const int li = layer >> 1;
        const int n_in = even ? N_AB : N_C;
        if (IN(pb + 0)) { F.ka = fresh_ka();
            pg8::Gemm g{F.XB(), F.WIN(), T, n_in, D, 64, 64, (size_t)T * 128, (size_t)n_in * 128}; pg8::StaticOrder S; S.init(T, n_in, F.G, (int)blockIdx.x);
            pg8::EpiProj E{F.BIG(), F.rstd(), even ? ((0xFull << 4) | (1ull << 16)) : ((1ull << 24) - 1ull), F.ka->inv[0], F.ka->inv[1], F.ka->inv[2], F.ka->inv[3], F.ka->inv[4], F.ka->inv[5], F.ka->inv[6], F.ka->inv[7]};
            if (PROBE == 5) { pg8::EpiNone E0; pg8::gemm_phase<pg8::EpiNone, pg8::StaticOrder, true>(F.lds + RING_OFF, g, S, E0, F.wave); }
            if (PROBE == 6) { pg8::EpiProjT<true> E0{E.O, E.rstd, E.ropemask, E.r0, E.r1, E.r2, E.r3, E.r4, E.r5, E.r6, E.r7}; pg8::gemm_phase<pg8::EpiProjT<true>, pg8::StaticOrder, true>(F.lds + RING_OFF, g, S, E0, F.wave); }
            for (int rep = 0; rep < (PROBE == 1 ? 2 : 1); ++rep) pg8::gemm_phase<pg8::EpiProj, pg8::StaticOrder, true>(F.lds + RING_OFF, g, S, E, F.wave);
        }
        SEAM(pb + 0);
        if (IN(pb + 1)) { F.lane = fresh_lane(); F.ka = fresh_ka();
            if (even) { if (PROBE == 2 || PROBE == 21) mfma_attn_a<true>(F, li); if (PROBE == 2 || PROBE == 22) mfma_attn_b<true>(F, li); mfma_attn_a<false>(F, li); mfma_attn_b<false>(F, li); }
            else { if (PROBE == 2 || PROBE == 23) mfma_attn_c<1, true>(F); mfma_attn_c<1, false>(F); }
        }
        if (!even) SEAM(pb + 1);
        if (IN(pb + 2) && !even) { F.lane = fresh_lane(); F.ka = fresh_ka(); if (PROBE == 2 || PROBE == 24) mfma_attn_c<2, true>(F); mfma_attn_c<2, false>(F); }
        SEAM(pb + 2);
        if (IN(pb + 3)) { F.ka = fresh_ka();
            const int k_out = even ? 2048 : 1024;
            pg8::Gemm g{F.BIG(), F.WOUT(), T, D, k_out, 64, 64, (size_t)T * 128, (size_t)D * 128};     pg8::StaticOrder S; S.init(T, D, F.G, (int)blockIdx.x);
            pg8::EpiPlain E{F.BIG() + (size_t)(even ? 32 : 16) * T * 64, D};
            if (PROBE == 5) { pg8::EpiNone E0; pg8::gemm_phase<pg8::EpiNone, pg8::StaticOrder, true>(F.lds + RING_OFF, g, S, E0, F.wave); }
            if (PROBE == 6) { pg8::EpiPlainT<true> E0{E.O, E.ldc}; pg8::gemm_phase<pg8::EpiPlainT<true>, pg8::StaticOrder, true>(F.lds + RING_OFF, g, S, E0, F.wave); }
            for (int rep = 0; rep < (PROBE == 1 ? 2 : 1); ++rep) pg8::gemm_phase<pg8::EpiPlain, pg8::StaticOrder, true>(F.lds + RING_OFF, g, S, E, F.wave);
        }
        SEAM(pb + 3);
        if (IN(pb + 4)) { F.lane = fresh_lane(); F.ka = fresh_ka(); const bf16_t* mp = F.BIG() + (size_t)(even ? 32 : 16) * T * 64;
            if (PROBE == 3) residual_rows<false, true>(F, mp, D, F.g_mix_post() + layer * D); residual_rows<false, false>(F, mp, D, F.g_mix_post() + layer * D); }
        SEAM(pb + 4);
        if (IN(pb + 5)) { F.ka = fresh_ka();
            pg8::Gemm g{F.XB(), F.WGU(), T, N_GU, D, 64, 64, (size_t)T * 128, (size_t)N_GU * 128}; pg8::StaticOrder S; S.init(T, N_GU, F.G, (int)blockIdx.x);
            pg8::EpiSwiGLU E{F.BIG(), FF, F.rstd()};
            if (PROBE == 5) { pg8::EpiNone E0; pg8::gemm_phase<pg8::EpiNone, pg8::StaticOrder, true>(F.lds + RING_OFF, g, S, E0, F.wave); }
            if (PROBE == 6) { pg8::EpiSwiGLUT<true> E0{E.O, E.ldc, E.rstd}; pg8::gemm_phase<pg8::EpiSwiGLUT<true>, pg8::StaticOrder, true>(F.lds + RING_OFF, g, S, E0, F.wave); }
            for (int rep = 0; rep < (PROBE == 1 ? 2 : 1); ++rep) pg8::gemm_phase<pg8::EpiSwiGLU, pg8::StaticOrder, true>(F.lds + RING_OFF, g, S, E, F.wave);
        }
        SEAM(pb + 5);
        if (IN(pb + 6)) { F.ka = fresh_ka();
            pg8::Gemm g{F.BIG(), F.WD(), T, D, FF, 64, 64, (size_t)T * 128, (size_t)D * 128}; pg8::StaticOrder S; S.init(T, D, F.G, (int)blockIdx.x);
            pg8::EpiPlain E{F.BIG() + (size_t)T * FF, D};
            if (PROBE == 5) { pg8::EpiNone E0; pg8::gemm_phase<pg8::EpiNone, pg8::StaticOrder, true>(F.lds + RING_OFF, g, S, E0, F.wave); }
            if (PROBE == 6) { pg8::EpiPlainT<true> E0{E.O, E.ldc}; pg8::gemm_phase<pg8::EpiPlainT<true>, pg8::StaticOrder, true>(F.lds + RING_OFF, g, S, E0, F.wave); }
            for (int rep = 0; rep < (PROBE == 1 ? 2 : 1); ++rep) pg8::gemm_phase<pg8::EpiPlain, pg8::StaticOrder, true>(F.lds + RING_OFF, g, S, E, F.wave);
        }
        SEAM(pb + 6);
        if (IN(pb + 7)) { F.lane = fresh_lane(); F.ka = fresh_ka(); const bf16_t* fp = F.BIG() + (size_t)T * FF;
            if (layer + 1 < DEPTH) { if (PROBE == 3) residual_rows<false, true>(F, fp, D, F.g_ffn_post() + layer * D); residual_rows<false, false>(F, fp, D, F.g_ffn_post() + layer * D); }
            else residual_rows<true, false>(F, fp, D, F.g_ffn_post() + layer * D);
            if (layer + 1 < DEPTH) { for (int rep = 0; rep < (PROBE == 4 ? 2 : 1); ++rep) { F.lane = fresh_lane(); F.ka = fresh_ka(); convert_layer_weights(F, layer + 1); } } }
        SEAM(pb + 7);
    }
#undef IN
#undef SEAM
}

extern "C" void kernel_launch(void* const* d_in, const int* in_sizes, int n_in, void* d_out, int out_size, void* d_ws, size_t ws_size, hipStream_t stream) {
    static int grid = 0;
    if (grid == 0) {
        if (n_in != 15 || out_size != T * D || ws_size < WS_END) { fprintf(stderr, "kernel_launch: unexpected shapes (n_in %d, out %d, ws %zu); nothing launched\n", n_in, out_size, ws_size); grid = -1; return; }
        int dev = 0, cus = 0, per_cu = 0;
        if (hipGetDevice(&dev) != hipSuccess || hipDeviceGetAttribute(&cus, hipDeviceAttributeMultiprocessorCount, dev) != hipSuccess) { grid = -1; return; }
        if (hipFuncSetAttribute((const void*)fwd, hipFuncAttributeMaxDynamicSharedMemorySize, LDS_BYTES) != hipSuccess) { fprintf(stderr, "kernel_launch: hipFuncSetAttribute failed\n"); grid = -1; return; }
        if (hipOccupancyMaxActiveBlocksPerMultiprocessor(&per_cu, (const void*)fwd, NWAVES * 64, LDS_BYTES) != hipSuccess || per_cu < 1)
            fprintf(stderr, "kernel_launch: note: occupancy query reports %d workgroups per CU\n", per_cu);
        (void)hipGetLastError();
        grid = cus;
    }
    if (grid < 0) return;
    if (hipMemsetAsync((char*)d_ws + WS_CTL, 0, CTL_ZERO_BYTES, stream) != hipSuccess) return;
    Args a{};
    for (int i = 0; i < 15; ++i) a.in[i] = (const float*)d_in[i];
    a.out = (float*)d_out; a.ws = (unsigned char*)d_ws;
    { const float la = (float)(-log(500000.0)); for (int j = 0; j < 8; ++j) { const float arg = (la * (float)j) * 0.125f; const float inv = (float)exp((double)arg); a.inv[j] = (float)((double)inv / 6.283185307179586476925); } }
#if MK_PER_PHASE
    for (int p = 0; p < NPH; ++p) { a.ph_lo = p; a.ph_hi = p + 1; a.li = p; hipLaunchKernelGGL(fwd, dim3(grid), dim3(NWAVES * 64), LDS_BYTES, stream, a); }
#else
    a.ph_lo = 0; a.ph_hi = NPH; a.li = 0;
    hipLaunchKernelGGL(fwd, dim3(grid), dim3(NWAVES * 64), LDS_BYTES, stream, a);
#endif
    const hipError_t le = hipPeekAtLastError();
    if (le != hipSuccess) fprintf(stderr, "kernel_launch: launch failed: %s\n", hipGetErrorName(le));
}
```

```cpp
#include <hip/hip_runtime.h>
#include <cstdio>
#include <cstdint>
#include <cmath>

#ifndef PROBE
#define PROBE 0
#endif
#ifndef MK_PER_PHASE
#define MK_PER_PHASE 0
#endif

constexpr int D = 2048, SEQ = 4096, NSEQ = 10, T = NSEQ * SEQ, FF = 5632, DEPTH = 4;
constexpr int N_AB = 4608, N_C = 9216, N_GU = 2 * FF;
constexpr float RMS_EPS = 1e-6f;
constexpr float LOG2E = 1.4426950408889634f;
constexpr float QSCALE = 0.125f * LOG2E;

constexpr size_t MiB = 1u << 20;
constexpr size_t WS_CTL = 0, CTL_ZERO_BYTES = 65536;
constexpr size_t WS_ROPE = 1 * MiB;
constexpr size_t WS_RSTD = 1 * MiB + 256 * 1024;
constexpr size_t WS_LSE = 2 * MiB;
constexpr size_t WS_WIN = 8 * MiB;
constexpr size_t WS_WOUT = 44 * MiB;
constexpr size_t WS_WGU = 52 * MiB;
constexpr size_t WS_WD = 96 * MiB;
constexpr size_t WS_XB = 120 * MiB;
constexpr size_t WS_BIG = 280 * MiB;
constexpr size_t WS_END = 1000 * MiB;
constexpr int CW_BAR = 4096;

constexpr int RING_OFF = 0, RING_BYTES = 131072;
constexpr int LDSCTL_OFF = RING_BYTES, MISC_OFF = LDSCTL_OFF + 320;
constexpr int BIAS_OFF = LDSCTL_OFF + 1024;
constexpr int RSB_OFF = LDSCTL_OFF + 4096;
constexpr int LDS_BYTES = 163840;
constexpr int NWAVES = 8;

#define GAS __attribute__((address_space(1)))
#define LAS __attribute__((address_space(3)))
typedef unsigned short bf16_t;
typedef short bf16x8 __attribute__((ext_vector_type(8)));
typedef float f32x4 __attribute__((ext_vector_type(4)));
typedef unsigned u32x4 __attribute__((ext_vector_type(4)));
typedef unsigned u32x2 __attribute__((ext_vector_type(2)));
typedef float f32x16 __attribute__((ext_vector_type(16)));
typedef short s16x4 __attribute__((ext_vector_type(4)));

__device__ __forceinline__ unsigned f2bf(float f) { unsigned u = __builtin_bit_cast(unsigned, f); return (u + 0x7fffu + ((u >> 16) & 1u)) >> 16; }
__device__ __forceinline__ unsigned pk2(float lo, float hi) { return f2bf(lo) | (f2bf(hi) << 16); }
__device__ __forceinline__ float bflo(unsigned w) { return __builtin_bit_cast(float, w << 16); }
__device__ __forceinline__ float bfhi(unsigned w) { return __builtin_bit_cast(float, w & 0xffff0000u); }
__device__ __forceinline__ unsigned cvt_pk_bf16(float lo, float hi) { unsigned r; asm volatile("v_cvt_pk_bf16_f32 %0, %1, %2" : "=v"(r) : "v"(lo), "v"(hi)); return r; }
__device__ __forceinline__ int fresh_lane() { int l; asm volatile("v_mbcnt_lo_u32_b32 %0, -1, 0\n\tv_mbcnt_hi_u32_b32 %0, -1, %0" : "=v"(l)); return l; }
__device__ __forceinline__ float wave_sum(float v) {
#pragma unroll
    for (int o = 1; o < 64; o <<= 1) v += __shfl_xor(v, o);
    return v;
}
__device__ __forceinline__ float wave_max(float v) {
#pragma unroll
    for (int o = 1; o < 64; o <<= 1) v = fmaxf(v, __shfl_xor(v, o));
    return v;
}

namespace pg8 {
constexpr int BM = 256, BK = 64, HALF = 128, HTB = HALF * BK * 2, STAGE_BYTES = 8 * HTB, NXCD = 8, WGM = 8;
__host__ __device__ __forceinline__ int lds_byte(int r, int c) { const int st = (r >> 4) * 2 + (c >> 5), rr = r & 15, cc = c & 31, ob = rr * 64 + cc * 2; return st * 1024 + (ob ^ (((ob >> 9) & 1) << 5)); }
__host__ __device__ __forceinline__ void stage_rc(int b, int& R, int& C) { const int st = b / 1024, sb = b % 1024, swz = sb ^ (((sb >> 9) & 1) << 5); R = (st >> 1) * 16 + swz / 64; C = (st & 1) * 32 + (swz % 64) / 2; }
__host__ __device__ __forceinline__ int perm32(int rho) { const int n = rho >> 4, i = rho & 15; return 8 * (i >> 2) + 4 * n + (i & 3); }

struct Unit { int pm, pn; };
struct Gemm { const bf16_t* A; const bf16_t* Bt; int M, N, K, lda, ldb; size_t kstepA, kstepB; };

struct StaticOrder {
    int nM, nN, nwg, G, c;
    __device__ void init(int M, int N, int G_, int c_) { nM = M / BM; nN = N / BM; nwg = nM * nN; G = G_; c = c_; }
    __device__ bool next(int i, Unit& u) const {
        const int per = G / NXCD; const long L = (G % NXCD == 0) ? (long)i * G + (long)(c % NXCD) * per + c / NXCD : (long)i * G + c;
        if (L >= nwg) return false;
        const int wgid = (int)L;
        const int nig = WGM * nN, gid = wgid / nig, fm = gid * WGM, gsz = (nM - fm) < WGM ? (nM - fm) : WGM;
        u.pm = fm + ((wgid % nig) % gsz); u.pn = (wgid % nig) / gsz; return true;
    }
    __device__ __forceinline__ void a_ready(const Unit&) const {}
    __device__ __forceinline__ void done(const Unit&) const {}
};

template <bool NS> struct EpiPlainT {
    static constexpr bool PERM = true, USES_RS = false;
    bf16_t* O; int ldc;
    __device__ __forceinline__ void operator()(const f32x4 (&acc)[2][2][4][2], const Unit& u, int wr, int wc, int fr, int fq, const LAS float*) const {
        const int row0 = u.pm * BM + wr * 64 + fr, col0 = u.pn * BM + wc * 32 + 8 * fq;
#pragma unroll
        for (int ai = 0; ai < 2; ++ai)
#pragma unroll
            for (int m = 0; m < 4; ++m) { bf16_t* rowp = O + (size_t)(row0 + ai * HALF + m * 16) * ldc + col0;
#pragma unroll
                for (int bj = 0; bj < 2; ++bj) { const f32x4 v0 = acc[ai][bj][m][0], v1 = acc[ai][bj][m][1];
                    u32x4 w; w.x = cvt_pk_bf16(v0[0], v0[1]); w.y = cvt_pk_bf16(v0[2], v0[3]); w.z = cvt_pk_bf16(v1[0], v1[1]); w.w = cvt_pk_bf16(v1[2], v1[3]);
                    if (NS) asm volatile("" :: "v"(w)); else *(u32x4*)(rowp + bj * HALF) = w; } }
    }
};
typedef EpiPlainT<false> EpiPlain;
template <bool NS> struct EpiProjT {
    static constexpr bool PERM = true, USES_RS = true;
    bf16_t* O; const float* rstd; unsigned long long ropemask; float r0, r1, r2, r3, r4, r5, r6, r7;
    __device__ __forceinline__ void operator()(const f32x4 (&acc)[2][2][4][2], const Unit& u, int wr, int wc, int fr, int fq, const LAS float* rsl) const {
        const int row0 = u.pm * BM + wr * 64 + fr;
        const size_t sl0 = (size_t)(u.pn * 4 + (wc >> 1)) * T;
        const int d0 = (wc & 1) * 32 + 8 * fq;
        const bool rotw = (((ropemask >> u.pn) & 1ull) != 0ull) && ((wc & 1) == 0);
        float rs[2][4];
#pragma unroll
        for (int ai = 0; ai < 2; ++ai)
#pragma unroll
            for (int m = 0; m < 4; ++m) rs[ai][m] = rsl[ai * HALF + wr * 64 + m * 16 + fr];
        const f32x4 iv = fq == 0 ? (f32x4){r0, r1, r2, r3} : (f32x4){r4, r5, r6, r7};
#pragma unroll
        for (int ai = 0; ai < 2; ++ai)
#pragma unroll
            for (int m = 0; m < 4; ++m) { const int row = row0 + ai * HALF + m * 16; bf16_t* rowp = O + (sl0 + row) * 64 + d0;
                f32x4 c4 = (f32x4){1.f, 1.f, 1.f, 1.f}, s4 = (f32x4){0.f, 0.f, 0.f, 0.f};
                if (rotw) { const float pos = (float)(row & (SEQ - 1));
#pragma unroll
                    for (int i = 0; i < 4; ++i) { const float rev = __builtin_amdgcn_fractf(pos * iv[i]); const float c = __builtin_amdgcn_cosf(rev), sn = __builtin_amdgcn_sinf(rev);
                        c4[i] = fq < 2 ? c : 1.f; s4[i] = fq < 2 ? sn : 0.f; } }
#pragma unroll
                for (int bj = 0; bj < 2; ++bj) { const f32x4 a = acc[ai][bj][m][0] * rs[ai][m], b = acc[ai][bj][m][1] * rs[ai][m];
                    const f32x4 v0 = a * c4 - b * s4, v1 = b * c4 + a * s4;
                    u32x4 w; w.x = cvt_pk_bf16(v0[0], v0[1]); w.y = cvt_pk_bf16(v0[2], v0[3]); w.z = cvt_pk_bf16(v1[0], v1[1]); w.w = cvt_pk_bf16(v1[2], v1[3]);
                    if (NS) asm volatile("" :: "v"(w)); else *(u32x4*)(rowp + (size_t)bj * 2 * T * 64) = w; } }
    }
};
typedef EpiProjT<false> EpiProj;
template <bool NS> struct EpiSwiGLUT {
    static constexpr bool PERM = true, USES_RS = true;
    bf16_t* O; int ldc; const float* rstd;
    __device__ __forceinline__ void operator()(const f32x4 (&acc)[2][2][4][2], const Unit& u, int wr, int wc, int fr, int fq, const LAS float* rsl) const {
        const int row0 = u.pm * BM + wr * 64 + fr;
        bf16_t* Ob = O + (size_t)(2 * u.pn + (wc >> 1)) * T * 64 + (wc & 1) * 32 + 8 * fq;
        float rsv[2][4];
#pragma unroll
        for (int ai = 0; ai < 2; ++ai)
#pragma unroll
            for (int m = 0; m < 4; ++m) rsv[ai][m] = rsl[ai * HALF + wr * 64 + m * 16 + fr];
#pragma unroll
        for (int ai = 0; ai < 2; ++ai)
#pragma unroll
            for (int m = 0; m < 4; ++m) { const int row = row0 + ai * HALF + m * 16; const float rs = rsv[ai][m];
                float h[8];
#pragma unroll
                for (int n = 0; n < 2; ++n)
#pragma unroll
                    for (int j = 0; j < 4; ++j) { const float g = acc[ai][0][m][n][j] * rs, up = acc[ai][1][m][n][j] * rs;
                        const float sg = __builtin_amdgcn_rcpf(1.0f + __builtin_amdgcn_exp2f(-g * LOG2E)); h[n * 4 + j] = g * sg * up; }
                u32x4 w; w.x = cvt_pk_bf16(h[0], h[1]); w.y = cvt_pk_bf16(h[2], h[3]); w.z = cvt_pk_bf16(h[4], h[5]); w.w = cvt_pk_bf16(h[6], h[7]);
                if (NS) asm volatile("" :: "v"(w)); else *(u32x4*)(Ob + (size_t)row * 64) = w; }
    }
};
typedef EpiSwiGLUT<false> EpiSwiGLU;

struct EpiNone {
    static constexpr bool PERM = true, USES_RS = false;
    __device__ __forceinline__ void operator()(const f32x4 (&acc)[2][2][4][2], const Unit&, int, int, int, int, const LAS float*) const {
#pragma unroll
        for (int a = 0; a < 2; ++a)
#pragma unroll
            for (int b = 0; b < 2; ++b)
#pragma unroll
                for (int m = 0; m < 4; ++m)
#pragma unroll
                    for (int n = 0; n < 2; ++n) asm volatile("" :: "v"(acc[a][b][m][n]));
    }
};
template <class Epi, class Sched, bool ALIGN_EPI>
__device__ __forceinline__ void gemm_phase(LAS unsigned char* lds, const Gemm g, const Sched& S, const Epi& E, int wid) {
    const int lane = fresh_lane(), tid = wid * 64 + lane, wr = wid >> 2, wc = wid & 3, fr = lane & 15, fq = lane >> 4;
    const int K = g.K, nt = K / BK, lda = g.lda, ldb = g.ldb;
    unsigned voffA[2], voffB[2];
#pragma unroll
    for (int i = 0; i < 2; ++i) { int R, C; stage_rc(tid * 16 + i * 8192, R, C); const int Rb = Epi::PERM ? ((R & ~31) + perm32(R & 31)) : R;
        voffA[i] = (unsigned)(R * lda + C) * 2u; voffB[i] = (unsigned)(Rb * ldb + C) * 2u; }
    const size_t kstepA = g.kstepA, kstep = g.kstepB;
    const size_t hstepA = (size_t)HALF * lda * 2, hstepB = (size_t)HALF * ldb * 2;
    const size_t tstepA = 2 * hstepA, tstepB = 2 * hstepB;
    const unsigned ldsw = (unsigned)wid * 1024u;
    const int aoff = lds_byte(wr * 64 + fr, fq * 8), boff = lds_byte(wc * 32 + fr, fq * 8);
#define PG8_SA(b, h) (((b) * 2 + (h)) * HTB)
#define PG8_SB(b, h) ((4 + (b) * 2 + (h)) * HTB)
#define PG8_STAGE(bufoff, gbase, voff) do { _Pragma("unroll") for (int _i = 0; _i < 2; ++_i) \
        __builtin_amdgcn_global_load_lds((const unsigned*)((const char*)(gbase) + (voff)[_i]), (LAS unsigned*)(lds + (bufoff) + ldsw + _i * 8192), 16, 0, 0); } while (0)
#define PG8_LDA(dst, b, h) do { _Pragma("unroll") for (int m = 0; m < 4; ++m) _Pragma("unroll") for (int k = 0; k < 2; ++k) dst[m][k] = *(const LAS bf16x8*)(lds + PG8_SA(b, h) + aoff + m * 2048 + k * 1024); } while (0)
#define PG8_LDB(dst, b, h) do { _Pragma("unroll") for (int n = 0; n < 2; ++n) _Pragma("unroll") for (int k = 0; k < 2; ++k) dst[n][k] = *(const LAS bf16x8*)(lds + PG8_SB(b, h) + boff + n * 2048 + k * 1024); } while (0)
#define PG8_MMA(ai, bj, At, Bt) do { __builtin_amdgcn_s_setprio(1); _Pragma("unroll") for (int m = 0; m < 4; ++m) _Pragma("unroll") for (int n = 0; n < 2; ++n) _Pragma("unroll") for (int k = 0; k < 2; ++k) \
        acc[ai][bj][m][n] = __builtin_amdgcn_mfma_f32_16x16x32_bf16(Bt[n][k], At[m][k], acc[ai][bj][m][n], 0, 0, 0); __builtin_amdgcn_s_setprio(0); } while (0)
#define PG8_WAIT_V(n) asm volatile("s_waitcnt vmcnt(" #n ")" ::: "memory")
#define PG8_WAIT_L(n) asm volatile("s_waitcnt lgkmcnt(" #n ")" ::: "memory")
#define PG8_BAR __builtin_amdgcn_s_barrier()
#define PG8_SCHED __builtin_amdgcn_sched_barrier(0)
    Unit cur, nxt; int ui = 0;
    if (!S.next(0, cur)) return;
    f32x4 acc[2][2][4][2];
#pragma unroll
    for (int a = 0; a < 2; ++a)
#pragma unroll
        for (int b = 0; b < 2; ++b)
#pragma unroll
            for (int m = 0; m < 4; ++m)
#pragma unroll
                for (int n = 0; n < 2; ++n) acc[a][b][m][n] = (f32x4){0.f, 0.f, 0.f, 0.f};
    bf16x8 At[4][2], B0[2][2], B1[2][2];
    const char* cA = (const char*)g.A + (size_t)cur.pm * tstepA; const char* cB = (const char*)g.Bt + (size_t)cur.pn * tstepB;
    LAS unsigned char* rsb = lds + (RSB_OFF - RING_OFF) + wid * 2048;
#define PG8_RS_STAGE(pm_, buf_) __builtin_amdgcn_global_load_lds((const unsigned*)(E.rstd + (size_t)(pm_) * BM + lane * 4), (LAS unsigned*)(rsb + (buf_) * 1024), 16, 0, 0)
    if constexpr (Epi::USES_RS) PG8_RS_STAGE(cur.pm, 0);
    S.a_ready(cur);
    PG8_STAGE(PG8_SB(0, 0), cB, voffB); PG8_STAGE(PG8_SB(0, 1), cB + hstepB, voffB); PG8_STAGE(PG8_SA(0, 0), cA, voffA); PG8_STAGE(PG8_SA(0, 1), cA + hstepA, voffA);
    if (wr == 1) PG8_BAR;
    PG8_WAIT_V(2); PG8_BAR;
    PG8_STAGE(PG8_SB(1, 0), cB + kstep, voffB); PG8_STAGE(PG8_SA(1, 0), cA + kstepA, voffA); PG8_STAGE(PG8_SB(1, 1), cB + hstepB + kstep, voffB);
    PG8_WAIT_V(6); PG8_BAR;
    for (;;) {
        const bool has_next = S.next(ui + 1, nxt);
        const char* nA = has_next ? (const char*)g.A + (size_t)nxt.pm * tstepA : cA; const char* nB = has_next ? (const char*)g.Bt + (size_t)nxt.pn * tstepB : cB;
        for (int t = 0; t < nt; t += 2) {
            const bool last = (t == nt - 2);
            const char* a1 = cA + (size_t)(t + 1) * kstepA;
            const char* a2 = last ? nA : cA + (size_t)(t + 2) * kstepA; const char* b2 = last ? nB : cB + (size_t)(t + 2) * kstep;
            const char* a3 = a2 + kstepA; const char* b3 = b2 + kstep;
            if (last && has_next) S.a_ready(nxt);
            PG8_LDB(B0, 0, 0); PG8_LDB(B1, 0, 1); PG8_SCHED; PG8_LDA(At, 0, 0); PG8_STAGE(PG8_SA(1, 1), a1 + hstepA, voffA);
            PG8_WAIT_V(8); PG8_WAIT_L(0); PG8_BAR; PG8_MMA(0, 0, At, B0); PG8_MMA(0, 1, At, B1); PG8_BAR; PG8_SCHED;
            PG8_LDA(At, 0, 1); PG8_STAGE(PG8_SB(0, 0), b2, voffB); PG8_STAGE(PG8_SB(0, 1), b2 + hstepB, voffB); PG8_STAGE(PG8_SA(0, 0), a2, voffA);
            PG8_WAIT_V(8); PG8_WAIT_L(0); PG8_BAR; PG8_MMA(1, 0, At, B0); PG8_MMA(1, 1, At, B1); PG8_BAR; PG8_SCHED;
            PG8_LDB(B0, 1, 0); PG8_LDB(B1, 1, 1); PG8_SCHED; PG8_LDA(At, 1, 0); PG8_STAGE(PG8_SA(0, 1), a2 + hstepA, voffA);
            PG8_WAIT_V(8); PG8_WAIT_L(0); PG8_BAR; PG8_MMA(0, 0, At, B0); PG8_MMA(0, 1, At, B1); PG8_BAR; PG8_SCHED;
            PG8_LDA(At, 1, 1); PG8_STAGE(PG8_SB(1, 0), b3, voffB); PG8_STAGE(PG8_SB(1, 1), b3 + hstepB, voffB); PG8_STAGE(PG8_SA(1, 0), a3, voffA);
            PG8_WAIT_V(8); PG8_WAIT_L(0); PG8_BAR; PG8_MMA(1, 0, At, B0); PG8_MMA(1, 1, At, B1); PG8_BAR; PG8_SCHED;
        }
        if constexpr (ALIGN_EPI) { if (wr == 0) PG8_BAR; }
        E(acc, cur, wr, wc, fr, fq, (const LAS float*)(rsb + (ui & 1) * 1024)); S.done(cur);
        if constexpr (Epi::USES_RS) { if (has_next) PG8_RS_STAGE(nxt.pm, (ui + 1) & 1); }
        if (!has_next) break;
#pragma unroll
        for (int a = 0; a < 2; ++a)
#pragma unroll
            for (int b = 0; b < 2; ++b)
#pragma unroll
                for (int m = 0; m < 4; ++m)
#pragma unroll
                    for (int n = 0; n < 2; ++n) acc[a][b][m][n] = (f32x4){0.f, 0.f, 0.f, 0.f};
        cur = nxt; cA = nA; cB = nB; ++ui;
        if constexpr (ALIGN_EPI) { if (wr == 1) PG8_BAR; }
    }
    PG8_WAIT_V(0);
    if constexpr (!ALIGN_EPI) { if (wr == 0) PG8_BAR; }
    PG8_BAR;
#undef PG8_RS_STAGE
#undef PG8_SA
#undef PG8_SB
#undef PG8_STAGE
#undef PG8_LDA
#undef PG8_LDB
#undef PG8_MMA
#undef PG8_WAIT_V
#undef PG8_WAIT_L
#undef PG8_BAR
#undef PG8_SCHED
}
}

#define XB_TMO      128
#define XB_XCNT(j)  (256  + 64 * (j))
#define XB_XSUB(j)  (1280 + 64 * (j))
#define XB_XGEN(j)  (2304 + 64 * (j))
#define XB_TOP      3328
#define XB_TOPGEN   3392
#define XCD_BAR_WORDS 3456
#define XB_SPIN_CAP (1u << 18)
__device__ __forceinline__ unsigned xb_ld(unsigned* p)              { return __hip_atomic_load(p, __ATOMIC_RELAXED, __HIP_MEMORY_SCOPE_AGENT); }
__device__ __forceinline__ unsigned xb_add(unsigned* p, unsigned v) { return __hip_atomic_fetch_add(p, v, __ATOMIC_RELAXED, __HIP_MEMORY_SCOPE_AGENT); }
__device__ __forceinline__ unsigned xb_xcc_id() { return (unsigned)__builtin_amdgcn_s_getreg((3 << 11) | 20) & 0xFu; }
#define XB_SPIN(cond, bar) do { unsigned _sp = 0; while (cond) { __builtin_amdgcn_s_sleep(1); \
    if ((++_sp & 255u) == 0u) { if (xb_ld(&(bar)[XB_TMO])) break; if (_sp > XB_SPIN_CAP) { atomicAdd(&(bar)[XB_TMO], 1u); break; } } } } while (0)
struct XcdBarrier { unsigned* bar; unsigned x; volatile LAS unsigned* st; };
__device__ __forceinline__ XcdBarrier xcd_barrier_post(unsigned* bar, volatile LAS unsigned* st) {
    XcdBarrier b; b.bar = bar; b.x = xb_xcc_id(); b.st = st;
    if (threadIdx.x == 0) (void)xb_add(&bar[XB_XCNT(b.x)], 1u);
    return b;
}
__device__ __forceinline__ void xcd_barrier_complete(unsigned* bar, unsigned x, unsigned& nloc, unsigned& nx) {
    const unsigned G = gridDim.x * gridDim.y * gridDim.z;
    unsigned sum, cnt, mine, sp = 0u;
    for (;;) {
        sum = 0u; cnt = 0u; mine = 0u;
#pragma unroll
        for (unsigned j = 0; j < 16; ++j) { const unsigned c = xb_ld(&bar[XB_XCNT(j)]); sum += c; cnt += (c > 0u) ? 1u : 0u; mine = (j == x) ? c : mine; }
        if (sum == G) break;
        __builtin_amdgcn_s_sleep(1);
        if ((++sp & 255u) == 0u) { if (xb_ld(&bar[XB_TMO])) break; if (sp > XB_SPIN_CAP) { atomicAdd(&bar[XB_TMO], 1u); break; } }
    }
    nloc = mine > 0u ? mine : 1u; nx = cnt > 0u ? cnt : 1u;
}
__device__ __forceinline__ void xcd_barrier(const XcdBarrier& b) {
    asm volatile("s_waitcnt vmcnt(0)" ::: "memory");
    __syncthreads();
    if (threadIdx.x == 0) {
        unsigned* bar = b.bar;
        __builtin_amdgcn_s_waitcnt(0);
        unsigned nloc = b.st[0], nx = b.st[1];
        if (nloc == 0u) { xcd_barrier_complete(bar, b.x, nloc, nx); b.st[0] = nloc; b.st[1] = nx; }
        const unsigned old = xb_add(&bar[XB_XSUB(b.x)], 1u);
        const unsigned gen = old / nloc;
        if (old + 1u == (gen + 1u) * nloc) {
            __builtin_amdgcn_fence(__ATOMIC_RELEASE, "agent");
            asm volatile("s_waitcnt vmcnt(0)" ::: "memory");
            const unsigned og = xb_add(&bar[XB_TOP], 1u);
            const unsigned tg = og / nx;
            if (og + 1u == (tg + 1u) * nx) xb_add(&bar[XB_TOPGEN], 1u);
            else XB_SPIN(xb_ld(&bar[XB_TOPGEN]) == tg, bar);
            __builtin_amdgcn_fence(__ATOMIC_ACQUIRE, "agent");
            xb_add(&bar[XB_XGEN(b.x)], 1u);
            asm volatile("s_waitcnt vmcnt(0)" ::: "memory");
        } else {
            XB_SPIN(xb_ld(&bar[XB_XGEN(b.x)]) == gen, bar);
            __builtin_amdgcn_fence(__ATOMIC_ACQUIRE, "agent");
            asm volatile("s_waitcnt vmcnt(0)" ::: "memory");
        }
    }
    __syncthreads();
}

struct Args {
    const float* in[15]; float* out; unsigned char* ws;
    float inv[8];
    int ph_lo, ph_hi, li, pad;
};
typedef const Args __attribute__((address_space(4))) KArgs;
__device__ __forceinline__ KArgs* fresh_ka() { KArgs* p = (KArgs*)__builtin_amdgcn_kernarg_segment_ptr(); asm volatile("" : "+s"(p)); return p; }
struct Frame {
    LAS unsigned char* lds;
    int lane, wave, G, gw, NGW, vcu;
    KArgs* ka;
    __device__ __forceinline__ const float* x_prompt() const { return ka->in[0]; }
    __device__ __forceinline__ const float* x_sample() const { return ka->in[1]; }
    __device__ __forceinline__ const float* g_mix_pre() const { return ka->in[2]; }
    __device__ __forceinline__ const float* g_mix_post() const { return ka->in[3]; }
    __device__ __forceinline__ const float* g_ffn_pre() const { return ka->in[4]; }
    __device__ __forceinline__ const float* g_ffn_post() const { return ka->in[5]; }
    __device__ __forceinline__ const float* w_in_ab() const { return ka->in[6]; }
    __device__ __forceinline__ const float* w_out_ab() const { return ka->in[7]; }
    __device__ __forceinline__ const float* rpb_a() const { return ka->in[8]; }
    __device__ __forceinline__ const float* sink_b() const { return ka->in[9]; }
    __device__ __forceinline__ const float* w_in_c() const { return ka->in[10]; }
    __device__ __forceinline__ const float* w_out_c() const { return ka->in[11]; }
    __device__ __forceinline__ const float* w_gate() const { return ka->in[12]; }
    __device__ __forceinline__ const float* w_up() const { return ka->in[13]; }
    __device__ __forceinline__ const float* w_down() const { return ka->in[14]; }
    __device__ __forceinline__ float* x() const { return ka->out; }
    __device__ __forceinline__ float* rope() const { return (float*)(ka->ws + WS_ROPE); }
    __device__ __forceinline__ float* rstd() const { return (float*)(ka->ws + WS_RSTD); }
    __device__ __forceinline__ float* lse() const { return (float*)(ka->ws + WS_LSE); }
    __device__ __forceinline__ bf16_t* WIN() const { return (bf16_t*)(ka->ws + WS_WIN); }
    __device__ __forceinline__ bf16_t* WOUT() const { return (bf16_t*)(ka->ws + WS_WOUT); }
    __device__ __forceinline__ bf16_t* WGU() const { return (bf16_t*)(ka->ws + WS_WGU); }
    __device__ __forceinline__ bf16_t* WD() const { return (bf16_t*)(ka->ws + WS_WD); }
    __device__ __forceinline__ bf16_t* XB() const { return (bf16_t*)(ka->ws + WS_XB); }
    __device__ __forceinline__ bf16_t* BIG() const { return (bf16_t*)(ka->ws + WS_BIG); }
};

__device__ __forceinline__ int ropeperm(int x) { const int d = x & 63; return (x & ~63) + ((d >= 4 && d < 8) ? d + 4 : (d >= 8 && d < 12) ? d - 4 : d); }
__device__ __forceinline__ void conv_map(int kind, int n, int& row, float& cs) {
    cs = 1.f; row = n;
    if (kind == 0) {
        if (n < 1024) { row = n; cs = QSCALE; }
        else if (n < 2048) row = 2048 + (n - 1024);
        else if (n < 3072) row = 3072 + (n - 2048);
        else if (n < 4096) { row = 1024 + ropeperm(n - 3072); cs = QSCALE; }
        else if (n < 4352) row = 4096 + ropeperm(n - 4096);
        else row = n;
    } else if (kind == 1) {
        const int gi = n / 3072, r = n % 3072, qkv = r >> 10, xx = r & 1023;
        row = (qkv * 3 + gi) * 1024 + (qkv < 2 ? ropeperm(xx) : xx); if (qkv == 0) cs = QSCALE;
    } else if (kind == 3) row = (n >> 7) * 256 + (n & 127);
    else if (kind == 4) row = (n >> 7) * 256 + 128 + (n & 127);
}
__device__ __forceinline__ void conv_item(const float* W, int K, int N, bf16_t* WT, int NR, const float* gain, int kind, LAS unsigned char* scr, int item, int lane) {
    const int nblk = N / 64, kb = item / nblk, nb = item % nblk, k0 = 64 * kb, n0 = 64 * nb;
    const int kq = lane >> 4, nq = 4 * (lane & 15);
    f32x4 v[16]; float gk[16];
#pragma unroll
    for (int i = 0; i < 16; ++i) v[i] = *(const f32x4*)(W + (size_t)(k0 + 4 * i + kq) * N + n0 + nq);
#pragma unroll
    for (int i = 0; i < 16; ++i) gk[i] = gain ? gain[k0 + 4 * i + kq] : 1.f;
    float cs[4];
#pragma unroll
    for (int e = 0; e < 4; ++e) { int row; conv_map(kind, n0 + nq + e, row, cs[e]); }
#pragma unroll
    for (int i = 0; i < 16; ++i) { u32x2 w; w.x = pk2(v[i][0] * gk[i] * cs[0], v[i][1] * gk[i] * cs[1]); w.y = pk2(v[i][2] * gk[i] * cs[2], v[i][3] * gk[i] * cs[3]);
        *(LAS u32x2*)(scr + (4 * i + kq) * 136 + 2 * nq) = w; }
    asm volatile("s_waitcnt lgkmcnt(0)" ::: "memory");
    const int c = lane & 7;
#pragma unroll
    for (int j = 0; j < 8; ++j) { const int n = (lane >> 3) + 8 * j; const LAS unsigned short* sp = (const LAS unsigned short*)(scr + (8 * c) * 136 + 2 * n);
        int row; float csd; conv_map(kind, n0 + n, row, csd);
        u32x4 o; o.x = (unsigned)sp[0] | ((unsigned)sp[68] << 16); o.y = (unsigned)sp[2 * 68] | ((unsigned)sp[3 * 68] << 16);
        o.z = (unsigned)sp[4 * 68] | ((unsigned)sp[5 * 68] << 16); o.w = (unsigned)sp[6 * 68] | ((unsigned)sp[7 * 68] << 16);
        *(u32x4*)(WT + ((size_t)kb * NR + row) * 64 + 8 * c) = o; }
    asm volatile("s_waitcnt lgkmcnt(0)" ::: "memory");
}
__device__ __forceinline__ void convert_layer_weights(Frame& F, int layer) {
    LAS unsigned char* scr = F.lds + RING_OFF + F.wave * 16384;
    const int i = layer >> 1; const bool even = (layer & 1) == 0;
    const int n_in = even ? N_AB : N_C, k_out = even ? 2048 : 1024;
    const int I_IN = (D / 64) * (n_in / 64), I_OUT = (k_out / 64) * (D / 64), I_G = (D / 64) * (FF / 64), I_D = (FF / 64) * (D / 64);
    const int total = I_IN + I_OUT + 2 * I_G + I_D;
    const float* w_in = even ? F.w_in_ab() + (size_t)i * D * N_AB : F.w_in_c() + (size_t)i * D * N_C;
    const float* w_out = even ? F.w_out_ab() + (size_t)i * 2048 * D : F.w_out_c() + (size_t)i * 1024 * D;
    for (int it = F.gw; it < total; it += F.NGW) {
        int r = it;
        if (r < I_IN) { conv_item(w_in, D, n_in, F.WIN(), n_in, F.g_mix_pre() + layer * D, even ? 0 : 1, scr, r, F.lane); continue; } r -= I_IN;
        if (r < I_OUT) { conv_item(w_out, k_out, D, F.WOUT(), D, nullptr, 2, scr, r, F.lane); continue; } r -= I_OUT;
        if (r < I_G) { conv_item(F.w_gate() + (size_t)layer * D * FF, D, FF, F.WGU(), N_GU, F.g_ffn_pre() + layer * D, 3, scr, r, F.lane); continue; } r -= I_G;
        if (r < I_G) { conv_item(F.w_up() + (size_t)layer * D * FF, D, FF, F.WGU(), N_GU, F.g_ffn_pre() + layer * D, 4, scr, r, F.lane); continue; } r -= I_G;
        conv_item(F.w_down() + (size_t)layer * FF * D, FF, D, F.WD(), D, nullptr, 2, scr, r, F.lane);
    }
}

__device__ __forceinline__ void prologue_rows(Frame& F) {
    for (int row = F.gw; row < T; row += F.NGW) {
        const float* src = row < 8 * SEQ ? F.x_prompt() + (size_t)row * D : F.x_sample() + (size_t)(row - 8 * SEQ) * D;
        float ss = 0.f;
#pragma unroll
        for (int j = 0; j < 4; ++j) { const int c = 8 * F.lane + 512 * j;
            const f32x4 a = *(const f32x4*)(src + c), b = *(const f32x4*)(src + c + 4);
            ss += (a[0] * a[0] + a[1] * a[1]) + (a[2] * a[2] + a[3] * a[3]) + (b[0] * b[0] + b[1] * b[1]) + (b[2] * b[2] + b[3] * b[3]);
            u32x4 w; w.x = pk2(a[0], a[1]); w.y = pk2(a[2], a[3]); w.z = pk2(b[0], b[1]); w.w = pk2(b[2], b[3]);
            *(u32x4*)(F.XB() + ((size_t)((F.lane >> 3) + 8 * j) * T + row) * 64 + 8 * (F.lane & 7)) = w; }
        ss = wave_sum(ss);
        if (F.lane == 0) F.rstd()[row] = 1.0f / sqrtf(ss * (1.0f / D) + RMS_EPS);
    }
}
template <bool FINAL, bool DUMMY> __device__ __forceinline__ void residual_rows(Frame& F, const bf16_t* mptr, int mpitch, const float* gain) {
    bf16_t* xbout = DUMMY ? (bf16_t*)F.x() : F.XB(); float* rsout = DUMMY ? F.lse() : F.rstd();
    for (int row = F.gw; row < T; row += F.NGW) {
        float mv[4][8]; float ss = 0.f;
#pragma unroll
        for (int j = 0; j < 4; ++j) { const int c = 8 * F.lane + 512 * j; const u32x4 w = *(const u32x4*)(mptr + (size_t)row * mpitch + c);
            mv[j][0] = bflo(w.x); mv[j][1] = bfhi(w.x); mv[j][2] = bflo(w.y); mv[j][3] = bfhi(w.y); mv[j][4] = bflo(w.z); mv[j][5] = bfhi(w.z); mv[j][6] = bflo(w.w); mv[j][7] = bfhi(w.w);
#pragma unroll
            for (int e = 0; e < 8; ++e) ss += mv[j][e] * mv[j][e]; }
        ss = wave_sum(ss);
        const float rs = 1.0f / sqrtf(ss * (1.0f / D) + RMS_EPS);
        float s2 = 0.f;
#pragma unroll
        for (int j = 0; j < 4; ++j) { const int c = 8 * F.lane + 512 * j;
            const size_t xo = ((size_t)((F.lane >> 3) + 8 * j) * T + row) * 64 + 8 * (F.lane & 7);
            const u32x4 xw = *(const u32x4*)(F.XB() + xo);
            const f32x4 a = (f32x4){bflo(xw.x), bfhi(xw.x), bflo(xw.y), bfhi(xw.y)}, b = (f32x4){bflo(xw.z), bfhi(xw.z), bflo(xw.w), bfhi(xw.w)};
            const f32x4 ga = *(const f32x4*)(gain + c), gb = *(const f32x4*)(gain + c + 4);
            f32x4 na, nb;
#pragma unroll
            for (int e = 0; e < 4; ++e) { na[e] = a[e] + mv[j][e] * rs * ga[e]; nb[e] = b[e] + mv[j][4 + e] * rs * gb[e]; }
            if (FINAL) { float* xo = F.x() + (size_t)row * D + c; *(f32x4*)xo = na; *(f32x4*)(xo + 4) = nb; }
            else {
                s2 += (na[0] * na[0] + na[1] * na[1]) + (na[2] * na[2] + na[3] * na[3]) + (nb[0] * nb[0] + nb[1] * nb[1]) + (nb[2] * nb[2] + nb[3] * nb[3]);
                u32x4 w; w.x = pk2(na[0], na[1]); w.y = pk2(na[2], na[3]); w.z = pk2(nb[0], nb[1]); w.w = pk2(nb[2], nb[3]);
                *(u32x4*)(xbout + xo) = w; } }
        if (!FINAL) { s2 = wave_sum(s2); if (F.lane == 0) rsout[row] = 1.0f / sqrtf(s2 * (1.0f / D) + RMS_EPS); }
    }
}

constexpr float ATT_NEG = -1e30f, ATT_FLOOR = -30000.f;
__device__ __forceinline__ void att_dma(LAS unsigned char* ring, const bf16_t* kbase, const bf16_t* vbase, long row0, int cstep, int jstride, int nch, unsigned vmask, int wave, int lane) {
    int j, ldsoff; const bf16_t* b0;
    if (wave < 4) { j = lane & 31; b0 = kbase + (2 * wave + (lane >> 5)) * 8; ldsoff = wave * 1024; }
    else { const int i = wave - 4; j = 16 * (i & 1) + (lane >> 2); b0 = vbase + 32 * (i >> 1) + 8 * (lane & 3); ldsoff = 4096 + (i >> 1) * 2048 + (i & 1) * 1024; }
    const bf16_t* p0 = b0 + (row0 + (long)j * jstride) * 64;
    for (int c = 0; c < nch; ++c)
        if ((vmask >> c) & 1u) __builtin_amdgcn_global_load_lds((const unsigned*)(p0 + (long)c * cstep * 64), (LAS unsigned*)(ring + c * 8192 + ldsoff), 16, 0, 0);
}
__device__ __forceinline__ f32x16 att_qk(const LAS unsigned char* Kc, const bf16x8 (&qr)[4], const f32x16& negm, int l31, int hi) {
    f32x16 s = negm;
#pragma unroll
    for (int d0 = 0; d0 < 4; ++d0) { const bf16x8 kf = *(const LAS bf16x8*)(Kc + (2 * d0 + hi) * 512 + l31 * 16); s = __builtin_amdgcn_mfma_f32_32x32x16_bf16(kf, qr[d0], s, 0, 0, 0); }
    return s;
}
__device__ __forceinline__ s16x4 att_vtr(const LAS unsigned char* p) { return __builtin_bit_cast(s16x4, __builtin_amdgcn_ds_read_tr16_b64_v4i16((LAS s16x4*)p)); }
constexpr float ATT_THR = 8.f;
__device__ __forceinline__ void att_softmax_pv(f32x16& s, const LAS unsigned char* Vc, float& m, f32x16& negm, float& l, f32x16& o0, f32x16& o1, bool first, int lane) {
    const int hi = lane >> 5;
    float cm = fmaxf(fmaxf(s[0], s[1]), fmaxf(s[2], s[3]));
#pragma unroll
    for (int r = 4; r < 16; r += 4) cm = fmaxf(cm, fmaxf(fmaxf(s[r], s[r + 1]), fmaxf(s[r + 2], s[r + 3])));
    { auto rr = __builtin_amdgcn_permlane32_swap(__float_as_uint(cm), __float_as_uint(cm), false, false); cm = fmaxf(__uint_as_float(rr[0]), __uint_as_float(rr[1])); }
    if (first || __any(cm > ATT_THR)) {
        const float dl = first ? fmaxf(cm, ATT_FLOOR) : fmaxf(cm, 0.f), alpha = first ? 0.f : __builtin_amdgcn_exp2f(-dl);
        m += dl; l *= alpha;
#pragma unroll
        for (int r = 0; r < 16; ++r) { s[r] -= dl; o0[r] *= alpha; o1[r] *= alpha; negm[r] = -m; }
    }
    float ps = 0.f;
#pragma unroll
    for (int r = 0; r < 16; ++r) { s[r] = __builtin_amdgcn_exp2f(s[r]); ps += s[r]; }
    l += ps;
    u32x4 pw0, pw1;
    pw0.x = cvt_pk_bf16(s[0], s[1]); pw0.y = cvt_pk_bf16(s[2], s[3]); pw0.z = cvt_pk_bf16(s[4], s[5]); pw0.w = cvt_pk_bf16(s[6], s[7]);
    pw1.x = cvt_pk_bf16(s[8], s[9]); pw1.y = cvt_pk_bf16(s[10], s[11]); pw1.z = cvt_pk_bf16(s[12], s[13]); pw1.w = cvt_pk_bf16(s[14], s[15]);
    const bf16x8 pb0 = __builtin_bit_cast(bf16x8, pw0), pb1 = __builtin_bit_cast(bf16x8, pw1);
    const LAS unsigned char* vb = Vc + (4 * hi + ((lane & 15) >> 2)) * 64 + ((lane >> 4) & 1) * 32 + (lane & 3) * 8;
#pragma unroll
    for (int d0 = 0; d0 < 2; ++d0) {
        const s16x4 a0 = att_vtr(vb + d0 * 2048), a1 = att_vtr(vb + d0 * 2048 + 512), b0 = att_vtr(vb + d0 * 2048 + 1024), b1 = att_vtr(vb + d0 * 2048 + 1536);
        const bf16x8 vf0 = (bf16x8){a0[0], a0[1], a0[2], a0[3], a1[0], a1[1], a1[2], a1[3]}, vf1 = (bf16x8){b0[0], b0[1], b0[2], b0[3], b1[0], b1[1], b1[2], b1[3]};
        if (d0 == 0) { o0 = __builtin_amdgcn_mfma_f32_32x32x16_bf16(vf0, pb0, o0, 0, 0, 0); o0 = __builtin_amdgcn_mfma_f32_32x32x16_bf16(vf1, pb1, o0, 0, 0, 0); }
        else { o1 = __builtin_amdgcn_mfma_f32_32x32x16_bf16(vf0, pb0, o1, 0, 0, 0); o1 = __builtin_amdgcn_mfma_f32_32x32x16_bf16(vf1, pb1, o1, 0, 0, 0); }
    }
}
__device__ __forceinline__ float att_half_sum(float v) { auto rr = __builtin_amdgcn_permlane32_swap(__float_as_uint(v), __float_as_uint(v), false, false); return __uint_as_float(rr[0]) + __uint_as_float(rr[1]); }
__device__ __forceinline__ void att_load_q(bf16x8 (&qr)[4], const bf16_t* qp  , int hi) {
#pragma unroll
    for (int d0 = 0; d0 < 4; ++d0) qr[d0] = *(const bf16x8*)(qp + 16 * d0 + 8 * hi);
}
__device__ __forceinline__ void att_store_o(bf16_t* op, const f32x16& o0, const f32x16& o1, float f, int hi) {
#pragma unroll
    for (int g = 0; g < 4; ++g) {
        u32x2 w0, w1; w0.x = cvt_pk_bf16(o0[4 * g] * f, o0[4 * g + 1] * f); w0.y = cvt_pk_bf16(o0[4 * g + 2] * f, o0[4 * g + 3] * f);
        w1.x = cvt_pk_bf16(o1[4 * g] * f, o1[4 * g + 1] * f); w1.y = cvt_pk_bf16(o1[4 * g + 2] * f, o1[4 * g + 3] * f);
        *(u32x2*)(op + 8 * g + 4 * hi) = w0; *(u32x2*)(op + 32 + 8 * g + 4 * hi) = w1; }
}
__device__ __forceinline__ void att_tri_mask(f32x16& s, int edge, int dq  ) {
#pragma unroll
    for (int r = 0; r < 16; ++r) { const int jj = (r & 3) + 8 * (r >> 2) + dq; const bool ok = edge < 0 ? (jj >= 0) : (jj <= 0); s[r] = ok ? s[r] : ATT_NEG; }
}

template <bool DUMMY> __device__ __forceinline__ void mfma_attn_b(Frame& F, int li) {
    LAS unsigned char* ring = F.lds + RING_OFF;
    const int lane = F.lane, l31 = lane & 31, hi = lane >> 5, wave = F.wave;
    for (int u = F.vcu; u < NSEQ * 4 * 64; u += F.G) {
        const int blk = u & 63, kvh = (u >> 6) & 3, b = u >> 8, t0 = blk * 64, sb = b * SEQ;
        unsigned vmask = 0u;
        for (int c = 0; c < 10; ++c) { const int kt = t0 - 128 + 32 * c; if (kt >= 0 && kt < SEQ) vmask |= 1u << c; }
        att_dma(ring, F.BIG() + (64 + kvh) * (size_t)T * 64, F.BIG() + (68 + kvh) * (size_t)T * 64, (long)sb + t0 - 128, 32, 1, 10, vmask, wave, lane);
        const int qt = wave & 1, head = kvh * 4 + (wave >> 1);
        const size_t qoff = ((size_t)(16 + head) * T + (sb + t0 + 32 * qt + l31)) * 64; bf16_t* qp = F.BIG() + qoff;
        bf16x8 qr[4]; att_load_q(qr, qp, hi);
        asm volatile("s_waitcnt vmcnt(0)" ::: "memory"); __syncthreads();
        float m = F.sink_b()[li * 16 + head] * LOG2E, l = hi == 0 ? 1.f : 0.f;
        f32x16 o0, o1, negm;
#pragma unroll
        for (int r = 0; r < 16; ++r) { o0[r] = 0.f; o1[r] = 0.f; negm[r] = -m; }
        for (int c = qt; c <= qt + 8; ++c) {
            if (!((vmask >> c) & 1u)) continue;
            f32x16 s = att_qk(ring + c * 8192, qr, negm, l31, hi);
            const int rel = c - qt - 4;
            if (rel == -4) att_tri_mask(s, -1, 4 * hi - l31); else if (rel == 4) att_tri_mask(s, 1, 4 * hi - l31);
            att_softmax_pv(s, ring + c * 8192 + 4096, m, negm, l, o0, o1, false, lane);
        }
        const float lt = att_half_sum(l);
        att_store_o(DUMMY ? (bf16_t*)F.x() + qoff : qp, o0, o1, 1.0f / lt, hi);
        __syncthreads();
    }
}
template <bool DUMMY> __device__ __forceinline__ void mfma_attn_a(Frame& F, int li) {
    LAS unsigned char* ring = F.lds + RING_OFF;
    LAS float* biasT = (LAS float*)(F.lds + BIAS_OFF);
    const int lane = F.lane, l31 = lane & 31, hi = lane >> 5, wave = F.wave;
    for (int u = F.vcu; u < NSEQ * 16 * 32; u += F.G) {
        const int C4 = u & 3, R = (u >> 2) & 7, h = (u >> 5) & 15, b = u >> 9, sb = b * SEQ;
        const int kr0 = min(max(8 * R - 4, 0), 56), krl = min(max(8 * R + 3, 0), 56) + 7, nch = krl - kr0 + 1;
        const int kc0 = min(max(16 * C4 - 8, 0), 32);
        att_dma(ring, F.BIG() + (32 + h) * (size_t)T * 64, F.BIG() + (48 + h) * (size_t)T * 64, (long)sb + kr0 * 64 + kc0, 64, 1, nch, 0xffffu, wave, lane);
        for (int i = wave * 64 + lane; i < 465; i += NWAVES * 64) biasT[i] = F.rpb_a()[(size_t)(li * 16 + h) * 465 + i] * LOG2E;
        const int wq = wave & 3;
        const int qrow_g = 8 * R + 2 * wq + (l31 >> 4), qcol_g = 16 * C4 + (l31 & 15);
        const size_t qoff = ((size_t)h * T + (sb + qrow_g * 64 + qcol_g)) * 64; bf16_t* qp = F.BIG() + qoff;
        bf16x8 qr[4]; att_load_q(qr, qp, hi);
        asm volatile("s_waitcnt vmcnt(0)" ::: "memory"); __syncthreads();
        if (wave < 4) {
            const int rs_l = min(max(qrow_g - 4, 0), 56), cs_l = min(max(qcol_g - 8, 0), 48);
            const int jb_l = 4 * hi - (cs_l - kc0), bbase_l = kc0 - qcol_g + 15 + 4 * hi;
            const int c_lo = min(max(8 * R + 2 * wq - 4, 0), 56) - kr0, c_hi = min(max(8 * R + 2 * wq + 1 - 4, 0), 56) + 7 - kr0;
            float m = 0.f, l = 0.f;
            f32x16 o0, o1, negm;
#pragma unroll
            for (int r = 0; r < 16; ++r) { o0[r] = 0.f; o1[r] = 0.f; negm[r] = 0.f; }
            for (int ci = c_lo; ci <= c_hi; ++ci) {
                const int c = ci == c_lo ? c_lo + 1 : ci == c_lo + 1 ? c_lo : ci;
                f32x16 s = att_qk(ring + c * 8192, qr, negm, l31, hi);
                const int kr = kr0 + c; const bool rowok = (kr >= rs_l) && (kr < rs_l + 8);
                const int bo = (kr - qrow_g + 7) * 31 + bbase_l;
                float bv[16];
#pragma unroll
                for (int r = 0; r < 16; ++r) bv[r] = biasT[min(max(bo + (r & 3) + 8 * (r >> 2), 0), 464)];
#pragma unroll
                for (int r = 0; r < 16; ++r) { const int jj = (r & 3) + 8 * (r >> 2); const bool ok = rowok && ((unsigned)(jj + jb_l) < 16u); s[r] = ok ? s[r] + bv[r] : ATT_NEG; }
                att_softmax_pv(s, ring + c * 8192 + 4096, m, negm, l, o0, o1, ci == c_lo, lane);
            }
            const float lt = att_half_sum(l);
            att_store_o(DUMMY ? (bf16_t*)F.x() + qoff : qp, o0, o1, 1.0f / lt, hi);
        }
        __syncthreads();
    }
}
template <int PASS, bool DUMMY> __device__ __forceinline__ void mfma_attn_c(Frame& F) {
    LAS unsigned char* ring = F.lds + RING_OFF;
    const int lane = F.lane, l31 = lane & 31, hi = lane >> 5, wave = F.wave;
    const int nunits = PASS == 1 ? 2 * 2560 : 2560;
    for (int u = F.vcu; u < nunits; u += F.G) {
        const int g = PASS == 1 ? 1 + u / 2560 : 0, v = u % 2560, b = v >> 8, h = (v >> 4) & 15, sub = v & 15;
        const int d = g == 0 ? 1 : g == 1 ? 4 : 16, lm = SEQ / d, res = sub % d, m0 = 256 * (sub / d), sb = b * SEQ;
        unsigned vmask = 0u;
        for (int c = 0; c < 12; ++c) { const int p = m0 - 64 + 32 * c; if (p >= 0 && p < lm) vmask |= 1u << c; }
        att_dma(ring, F.BIG() + (48 + g * 16 + h) * (size_t)T * 64, F.BIG() + (96 + g * 16 + h) * (size_t)T * 64, (long)sb + (long)(m0 - 64) * d + res, 32 * d, d, 12, vmask, wave, lane);
        const size_t qrow = (size_t)(sb + (m0 + 32 * wave + l31) * d + res);
        const size_t qoff = ((size_t)(g * 16 + h) * T + qrow) * 64; bf16_t* qp = F.BIG() + qoff;
        bf16x8 qr[4]; att_load_q(qr, qp, hi);
        asm volatile("s_waitcnt vmcnt(0)" ::: "memory"); __syncthreads();
        float m = 0.f, l = 0.f; bool first = true;
        f32x16 o0, o1, negm;
#pragma unroll
        for (int r = 0; r < 16; ++r) { o0[r] = 0.f; o1[r] = 0.f; negm[r] = 0.f; }
        for (int c = wave; c <= wave + 4; ++c) {
            if (!((vmask >> c) & 1u)) continue;
            f32x16 s = att_qk(ring + c * 8192, qr, negm, l31, hi);
            const int rel = c - wave - 2;
            if (rel == -2) att_tri_mask(s, -1, 4 * hi - l31); else if (rel == 2) att_tri_mask(s, 1, 4 * hi - l31);
            att_softmax_pv(s, ring + c * 8192 + 4096, m, negm, l, o0, o1, first, lane); first = false;
        }
        const float lt = att_half_sum(l);
        const float L = m + __builtin_amdgcn_logf(lt);
        if (PASS == 1) {
            att_store_o(DUMMY ? (bf16_t*)F.x() + qoff : qp, o0, o1, 1.0f / lt, hi);
            if (hi == 0) F.lse()[((size_t)(g - 1) * T + qrow) * 16 + h] = L;
        } else {
            const float L1 = F.lse()[(qrow) * 16 + h], L2 = F.lse()[((size_t)T + qrow) * 16 + h];
            const float Lm = fmaxf(L, fmaxf(L1, L2));
            const float w0 = __builtin_amdgcn_exp2f(L - Lm), w1 = __builtin_amdgcn_exp2f(L1 - Lm), w2 = __builtin_amdgcn_exp2f(L2 - Lm), iw = 1.0f / (w0 + w1 + w2);
            const float f0 = w0 * iw / lt, f1 = w1 * iw, f2 = w2 * iw;
            const bf16_t* p1 = qp + 16 * (size_t)T * 64; const bf16_t* p2 = qp + 32 * (size_t)T * 64;
#pragma unroll
            for (int g4 = 0; g4 < 4; ++g4)
#pragma unroll
                for (int d0 = 0; d0 < 2; ++d0) {
                    const u32x2 a = *(const u32x2*)(p1 + 32 * d0 + 8 * g4 + 4 * hi), c2 = *(const u32x2*)(p2 + 32 * d0 + 8 * g4 + 4 * hi);
                    const f32x16& o = d0 == 0 ? o0 : o1;
                    const float r0 = o[4 * g4] * f0 + bflo(a.x) * f1 + bflo(c2.x) * f2, r1 = o[4 * g4 + 1] * f0 + bfhi(a.x) * f1 + bfhi(c2.x) * f2;
                    const float r2 = o[4 * g4 + 2] * f0 + bflo(a.y) * f1 + bflo(c2.y) * f2, r3 = o[4 * g4 + 3] * f0 + bfhi(a.y) * f1 + bfhi(c2.y) * f2;
                    u32x2 w; w.x = cvt_pk_bf16(r0, r1); w.y = cvt_pk_bf16(r2, r3);
                    *(u32x2*)((DUMMY ? (bf16_t*)F.x() + qoff : qp) + 32 * d0 + 8 * g4 + 4 * hi) = w; }
        }
        __syncthreads();
    }
}

constexpr int NPH = 1 + DEPTH * 8;
__global__ void __launch_bounds__(NWAVES * 64, 2) fwd(Args args) {
    extern __shared__ __attribute__((aligned(16))) unsigned char lds[];
    Frame F;
    F.lds = (LAS unsigned char*)lds;
    F.wave = __builtin_amdgcn_readfirstlane((int)threadIdx.x >> 6); F.lane = fresh_lane(); F.ka = fresh_ka();
    F.G = gridDim.x; F.gw = blockIdx.x * NWAVES + F.wave; F.NGW = F.G * NWAVES;
    F.vcu = (F.G % 8 == 0) ? (int)(blockIdx.x % 8) * (F.G / 8) + (int)(blockIdx.x / 8) : (int)blockIdx.x;
    F.ka = fresh_ka();
    unsigned char* ws = args.ws;
    volatile LAS unsigned* MISC = (volatile LAS unsigned*)(F.lds + MISC_OFF);
    for (int u = F.wave * 64 + F.lane; u < (LDS_BYTES - LDSCTL_OFF) / 4; u += NWAVES * 64) ((LAS unsigned*)(F.lds + LDSCTL_OFF))[u] = 0u;
    __syncthreads();
    unsigned* barw = (unsigned*)(ws + WS_CTL) + CW_BAR;
    XcdBarrier bar; bar.bar = barw; bar.x = 0; bar.st = nullptr;
    if (!MK_PER_PHASE) bar = xcd_barrier_post(barw, MISC + 8);
    const int lo = args.ph_lo, hi = args.ph_hi;
#define IN(k) (lo <= (k) && (k) < hi)
#define SEAM(k) do { if (!MK_PER_PHASE) { if (IN(k) && IN((k) + 1)) xcd_barrier(bar); } } while (0)

    if (IN(0)) {
        F.lane = fresh_lane(); F.ka = fresh_ka();
        prologue_rows(F);
        for (int rep = 0; rep < (PROBE == 4 ? 2 : 1); ++rep) convert_layer_weights(F, 0);
    }
    SEAM(0);
    for (int layer = 0; layer < DEPTH; ++layer) {
        const int pb = 1 + 8 * layer; const bool even = (layer & 1) == 0; const int li = layer >> 1;
        const int n_in = even ? N_AB : N_C;
        if (IN(pb + 0)) { F.ka = fresh_ka();
            pg8::Gemm g{F.XB(), F.WIN(), T, n_in, D, 64, 64, (size_t)T * 128, (size_t)n_in * 128}; pg8::StaticOrder S; S.init(T, n_in, F.G, (int)blockIdx.x);
            pg8::EpiProj E{F.BIG(), F.rstd(), even ? ((0xFull << 4) | (1ull << 16)) : ((1ull << 24) - 1ull), F.ka->inv[0], F.ka->inv[1], F.ka->inv[2], F.ka->inv[3], F.ka->inv[4], F.ka->inv[5], F.ka->inv[6], F.ka->inv[7]};
            if (PROBE == 5) { pg8::EpiNone E0; pg8::gemm_phase<pg8::EpiNone, pg8::StaticOrder, true>(F.lds + RING_OFF, g, S, E0, F.wave); }
            if (PROBE == 6) { pg8::EpiProjT<true> E0{E.O, E.rstd, E.ropemask, E.r0, E.r1, E.r2, E.r3, E.r4, E.r5, E.r6, E.r7}; pg8::gemm_phase<pg8::EpiProjT<true>, pg8::StaticOrder, true>(F.lds + RING_OFF, g, S, E0, F.wave); }
            for (int rep = 0; rep < (PROBE == 1 ? 2 : 1); ++rep) pg8::gemm_phase<pg8::EpiProj, pg8::StaticOrder, true>(F.lds + RING_OFF, g, S, E, F.wave);
        }
        SEAM(pb + 0);
        if (IN(pb + 1)) { F.lane = fresh_lane(); F.ka = fresh_ka();
            if (even) { if (PROBE == 2 || PROBE == 21) mfma_attn_a<true>(F, li); if (PROBE == 2 || PROBE == 22) mfma_attn_b<true>(F, li); mfma_attn_a<false>(F, li); mfma_attn_b<false>(F, li); }
            else { if (PROBE == 2 || PROBE == 23) mfma_attn_c<1, true>(F); mfma_attn_c<1, false>(F); }
        }
        if (!even) SEAM(pb + 1);
        if (IN(pb + 2) && !even) { F.lane = fresh_lane(); F.ka = fresh_ka(); if (PROBE == 2 || PROBE == 24) mfma_attn_c<2, true>(F); mfma_attn_c<2, false>(F); }
        SEAM(pb + 2);
        if (IN(pb + 3)) { F.ka = fresh_ka();
            const int k_out = even ? 2048 : 1024;
            pg8::Gemm g{F.BIG(), F.WOUT(), T, D, k_out, 64, 64, (size_t)T * 128, (size_t)D * 128};     pg8::StaticOrder S; S.init(T, D, F.G, (int)blockIdx.x);
            pg8::EpiPlain E{F.BIG() + (size_t)(even ? 32 : 16) * T * 64, D};
            if (PROBE == 5) { pg8::EpiNone E0; pg8::gemm_phase<pg8::EpiNone, pg8::StaticOrder, true>(F.lds + RING_OFF, g, S, E0, F.wave); }
            if (PROBE == 6) { pg8::EpiPlainT<true> E0{E.O, E.ldc}; pg8::gemm_phase<pg8::EpiPlainT<true>, pg8::StaticOrder, true>(F.lds + RING_OFF, g, S, E0, F.wave); }
            for (int rep = 0; rep < (PROBE == 1 ? 2 : 1); ++rep) pg8::gemm_phase<pg8::EpiPlain, pg8::StaticOrder, true>(F.lds + RING_OFF, g, S, E, F.wave);
        }
        SEAM(pb + 3);
        if (IN(pb + 4)) { F.lane = fresh_lane(); F.ka = fresh_ka(); const bf16_t* mp = F.BIG() + (size_t)(even ? 32 : 16) * T * 64;
            if (PROBE == 3) residual_rows<false, true>(F, mp, D, F.g_mix_post() + layer * D); residual_rows<false, false>(F, mp, D, F.g_mix_post() + layer * D); }
        SEAM(pb + 4);
        if (IN(pb + 5)) { F.ka = fresh_ka();
            pg8::Gemm g{F.XB(), F.WGU(), T, N_GU, D, 64, 64, (size_t)T * 128, (size_t)N_GU * 128}; pg8::StaticOrder S; S.init(T, N_GU, F.G, (int)blockIdx.x);
            pg8::EpiSwiGLU E{F.BIG(), FF, F.rstd()};
            if (PROBE == 5) { pg8::EpiNone E0; pg8::gemm_phase<pg8::EpiNone, pg8::StaticOrder, true>(F.lds + RING_OFF, g, S, E0, F.wave); }
            if (PROBE == 6) { pg8::EpiSwiGLUT<true> E0{E.O, E.ldc, E.rstd}; pg8::gemm_phase<pg8::EpiSwiGLUT<true>, pg8::StaticOrder, true>(F.lds + RING_OFF, g, S, E0, F.wave); }
            for (int rep = 0; rep < (PROBE == 1 ? 2 : 1); ++rep) pg8::gemm_phase<pg8::EpiSwiGLU, pg8::StaticOrder, true>(F.lds + RING_OFF, g, S, E, F.wave);
        }
        SEAM(pb + 5);
        if (IN(pb + 6)) { F.ka = fresh_ka();
            pg8::Gemm g{F.BIG(), F.WD(), T, D, FF, 64, 64, (size_t)T * 128, (size_t)D * 128}; pg8::StaticOrder S; S.init(T, D, F.G, (int)blockIdx.x);
            pg8::EpiPlain E{F.BIG() + (size_t)T * FF, D};
            if (PROBE == 5) { pg8::EpiNone E0; pg8::gemm_phase<pg8::EpiNone, pg8::StaticOrder, true>(F.lds + RING_OFF, g, S, E0, F.wave); }
            if (PROBE == 6) { pg8::EpiPlainT<true> E0{E.O, E.ldc}; pg8::gemm_phase<pg8::EpiPlainT<true>, pg8::StaticOrder, true>(F.lds + RING_OFF, g, S, E0, F.wave); }
            for (int rep = 0; rep < (PROBE == 1 ? 2 : 1); ++rep) pg8::gemm_phase<pg8::EpiPlain, pg8::StaticOrder, true>(F.lds + RING_OFF, g, S, E, F.wave);
        }
        SEAM(pb + 6);
        if (IN(pb + 7)) { F.lane = fresh_lane(); F.ka = fresh_ka(); const bf16_t* fp = F.BIG() + (size_t)T * FF;
            if (layer + 1 < DEPTH) { if (PROBE == 3) residual_rows<false, true>(F, fp, D, F.g_ffn_post() + layer * D); residual_rows<false, false>(F, fp, D, F.g_ffn_post() + layer * D); }
            else residual_rows<true, false>(F, fp, D, F.g_ffn_post() + layer * D);
            if (layer + 1 < DEPTH) { for (int rep = 0; rep < (PROBE == 4 ? 2 : 1); ++rep) { F.lane = fresh_lane(); F.ka = fresh_ka(); convert_layer_weights(F, layer + 1); } } }
        SEAM(pb + 7);
    }
#undef IN
#undef SEAM
}

extern "C" void kernel_launch(void* const* d_in, const int* in_sizes, int n_in, void* d_out, int out_size, void* d_ws, size_t ws_size, hipStream_t stream) {
    static int grid = 0;
    if (grid == 0) {
        if (n_in != 15 || out_size != T * D || ws_size < WS_END) { fprintf(stderr, "kernel_launch: unexpected shapes (n_in %d, out %d, ws %zu); nothing launched\n", n_in, out_size, ws_size); grid = -1; return; }
        int dev = 0, cus = 0, per_cu = 0;
        if (hipGetDevice(&dev) != hipSuccess || hipDeviceGetAttribute(&cus, hipDeviceAttributeMultiprocessorCount, dev) != hipSuccess) { grid = -1; return; }
        if (hipFuncSetAttribute((const void*)fwd, hipFuncAttributeMaxDynamicSharedMemorySize, LDS_BYTES) != hipSuccess) { fprintf(stderr, "kernel_launch: hipFuncSetAttribute failed\n"); grid = -1; return; }
        if (hipOccupancyMaxActiveBlocksPerMultiprocessor(&per_cu, (const void*)fwd, NWAVES * 64, LDS_BYTES) != hipSuccess || per_cu < 1)
            fprintf(stderr, "kernel_launch: note: occupancy query reports %d workgroups per CU\n", per_cu);
        (void)hipGetLastError();
        grid = cus;
    }
    if (grid < 0) return;
    if (hipMemsetAsync((char*)d_ws + WS_CTL, 0, CTL_ZERO_BYTES, stream) != hipSuccess) return;
    Args a{};
    for (int i = 0; i < 15; ++i) a.in[i] = (const float*)d_in[i];
    a.out = (float*)d_out; a.ws = (unsigned char*)d_ws;
    { const float la = (float)(-log(500000.0)); for (int j = 0; j < 8; ++j) { const float arg = (la * (float)j) * 0.125f; const float inv = (float)exp((double)arg); a.inv[j] = (float)((double)inv / 6.283185307179586476925); } }
#if MK_PER_PHASE
    for (int p = 0; p < NPH; ++p) { a.ph_lo = p; a.ph_hi = p + 1; a.li = p; hipLaunchKernelGGL(fwd, dim3(grid), dim3(NWAVES * 64), LDS_BYTES, stream, a); }
#else
    a.ph_lo = 0; a.ph_hi = NPH; a.li = 0;
    hipLaunchKernelGGL(fwd, dim3(grid), dim3(NWAVES * 64), LDS_BYTES, stream, a);
#endif
    const hipError_t le = hipPeekAtLastError();
    if (le != hipSuccess) fprintf(stderr, "kernel_launch: launch failed: %s\n", hipGetErrorName(le));
}
```

```cpp
#include <hip/hip_runtime.h>
#include <cstdio>
#include <cstdint>
#include <cmath>

#ifndef PROBE
#define PROBE 0
#endif
#ifndef MK_PER_PHASE
#define MK_PER_PHASE 0
#endif

constexpr int D = 2048, SEQ = 4096, NSEQ = 10, T = NSEQ * SEQ, FF = 5632, DEPTH = 4;
constexpr int N_AB = 4608, N_C = 9216, N_GU = 2 * FF;
constexpr float RMS_EPS = 1e-6f;
constexpr float LOG2E = 1.4426950408889634f;
constexpr float QSCALE = 0.125f * LOG2E;

constexpr size_t MiB = 1u << 20;
constexpr size_t WS_CTL = 0, CTL_ZERO_BYTES = 65536;
constexpr size_t WS_ROPE = 1 * MiB;
constexpr size_t WS_RSTD = 1 * MiB + 256 * 1024;
constexpr size_t WS_LSE = 2 * MiB;
constexpr size_t WS_WIN = 8 * MiB;
constexpr size_t WS_WOUT = 44 * MiB;
constexpr size_t WS_WGU = 52 * MiB;
constexpr size_t WS_WD = 96 * MiB;
constexpr size_t WS_XB = 120 * MiB;
constexpr size_t WS_BIG = 280 * MiB;
constexpr size_t WS_END = 1000 * MiB;
constexpr int CW_BAR = 4096;

constexpr int RING_OFF = 0, RING_BYTES = 131072;
constexpr int LDSCTL_OFF = RING_BYTES, MISC_OFF = LDSCTL_OFF + 320;
constexpr int BIAS_OFF = LDSCTL_OFF + 1024;
constexpr int RSB_OFF = LDSCTL_OFF + 4096;
constexpr int LDS_BYTES = 163840;
constexpr int NWAVES = 8;

#define GAS __attribute__((address_space(1)))
#define LAS __attribute__((address_space(3)))
typedef unsigned short bf16_t;
typedef short bf16x8 __attribute__((ext_vector_type(8)));
typedef float f32x4 __attribute__((ext_vector_type(4)));
typedef unsigned u32x4 __attribute__((ext_vector_type(4)));
typedef unsigned u32x2 __attribute__((ext_vector_type(2)));
typedef float f32x16 __attribute__((ext_vector_type(16)));
typedef short s16x4 __attribute__((ext_vector_type(4)));

__device__ __forceinline__ unsigned f2bf(float f) { unsigned u = __builtin_bit_cast(unsigned, f); return (u + 0x7fffu + ((u >> 16) & 1u)) >> 16; }
__device__ __forceinline__ unsigned pk2(float lo, float hi) { return f2bf(lo) | (f2bf(hi) << 16); }
__device__ __forceinline__ float bflo(unsigned w) { return __builtin_bit_cast(float, w << 16); }
__device__ __forceinline__ float bfhi(unsigned w) { return __builtin_bit_cast(float, w & 0xffff0000u); }
__device__ __forceinline__ unsigned cvt_pk_bf16(float lo, float hi) { unsigned r; asm volatile("v_cvt_pk_bf16_f32 %0, %1, %2" : "=v"(r) : "v"(lo), "v"(hi)); return r; }
__device__ __forceinline__ int fresh_lane() { int l; asm volatile("v_mbcnt_lo_u32_b32 %0, -1, 0\n\tv_mbcnt_hi_u32_b32 %0, -1, %0" : "=v"(l)); return l; }
__device__ __forceinline__ float wave_sum(float v) {
#pragma unroll
    for (int o = 1; o < 64; o <<= 1) v += __shfl_xor(v, o);
    return v;
}
__device__ __forceinline__ float wave_max(float v) {
#pragma unroll
    for (int o = 1; o < 64; o <<= 1) v = fmaxf(v, __shfl_xor(v, o));
    return v;
}

namespace pg8 {
constexpr int BM = 256, BK = 64, HALF = 128, HTB = HALF * BK * 2, STAGE_BYTES = 8 * HTB, NXCD = 8, WGM = 8;
__host__ __device__ __forceinline__ int lds_byte(int r, int c) { const int st = (r >> 4) * 2 + (c >> 5), rr = r & 15, cc = c & 31, ob = rr * 64 + cc * 2; return st * 1024 + (ob ^ (((ob >> 9) & 1) << 5)); }
__host__ __device__ __forceinline__ void stage_rc(int b, int& R, int& C) { const int st = b / 1024, sb = b % 1024, swz = sb ^ (((sb >> 9) & 1) << 5); R = (st >> 1) * 16 + swz / 64; C = (st & 1) * 32 + (swz % 64) / 2; }
__host__ __device__ __forceinline__ int perm32(int rho) { const int n = rho >> 4, i = rho & 15; return 8 * (i >> 2) + 4 * n + (i & 3); }

struct Unit { int pm, pn; };
struct Gemm { const bf16_t* A; const bf16_t* Bt; int M, N, K, lda, ldb; size_t kstepA, kstepB; };

struct StaticOrder {
    int nM, nN, nwg, G, c;
    __device__ void init(int M, int N, int G_, int c_) { nM = M / BM; nN = N / BM; nwg = nM * nN; G = G_; c = c_; }
    __device__ bool next(int i, Unit& u) const {
        const int per = G / NXCD; const long L = (G % NXCD == 0) ? (long)i * G + (long)(c % NXCD) * per + c / NXCD : (long)i * G + c;
        if (L >= nwg) return false;
        const int wgid = (int)L;
        const int nig = WGM * nN, gid = wgid / nig, fm = gid * WGM, gsz = (nM - fm) < WGM ? (nM - fm) : WGM;
        u.pm = fm + ((wgid % nig) % gsz); u.pn = (wgid % nig) / gsz; return true;
    }
    __device__ __forceinline__ void a_ready(const Unit&) const {}
    __device__ __forceinline__ void done(const Unit&) const {}
};

template <bool NS> struct EpiPlainT {
    static constexpr bool PERM = true, USES_RS = false;
    bf16_t* O; int ldc;
    __device__ __forceinline__ void operator()(const f32x4 (&acc)[2][2][4][2], const Unit& u, int wr, int wc, int fr, int fq, const LAS float*) const {
        const int row0 = u.pm * BM + wr * 64 + fr, col0 = u.pn * BM + wc * 32 + 8 * fq;
#pragma unroll
        for (int ai = 0; ai < 2; ++ai)
#pragma unroll
            for (int m = 0; m < 4; ++m) { bf16_t* rowp = O + (size_t)(row0 + ai * HALF + m * 16) * ldc + col0;
#pragma unroll
                for (int bj = 0; bj < 2; ++bj) { const f32x4 v0 = acc[ai][bj][m][0], v1 = acc[ai][bj][m][1];
                    u32x4 w; w.x = cvt_pk_bf16(v0[0], v0[1]); w.y = cvt_pk_bf16(v0[2], v0[3]); w.z = cvt_pk_bf16(v1[0], v1[1]); w.w = cvt_pk_bf16(v1[2], v1[3]);
                    if (NS) asm volatile("" :: "v"(w)); else *(u32x4*)(rowp + bj * HALF) = w; } }
    }
};
typedef EpiPlainT<false> EpiPlain;
template <bool NS> struct EpiProjT {
    static constexpr bool PERM = true, USES_RS = true;
    bf16_t* O; const float* rstd; unsigned long long ropemask; float r0, r1, r2, r3, r4, r5, r6, r7;
    __device__ __forceinline__ void operator()(const f32x4 (&acc)[2][2][4][2], const Unit& u, int wr, int wc, int fr, int fq, const LAS float* rsl) const {
        const int row0 = u.pm * BM + wr * 64 + fr;
        const size_t sl0 = (size_t)(u.pn * 4 + (wc >> 1)) * T;
        const int d0 = (wc & 1) * 32 + 8 * fq;
        const bool rotw = (((ropemask >> u.pn) & 1ull) != 0ull) && ((wc & 1) == 0);
        float rs[2][4];
#pragma unroll
        for (int ai = 0; ai < 2; ++ai)
#pragma unroll
            for (int m = 0; m < 4; ++m) rs[ai][m] = rsl[ai * HALF + wr * 64 + m * 16 + fr];
        const f32x4 iv = fq == 0 ? (f32x4){r0, r1, r2, r3} : (f32x4){r4, r5, r6, r7};
#pragma unroll
        for (int ai = 0; ai < 2; ++ai)
#pragma unroll
            for (int m = 0; m < 4; ++m) { const int row = row0 + ai * HALF + m * 16; bf16_t* rowp = O + (sl0 + row) * 64 + d0;
                f32x4 c4 = (f32x4){1.f, 1.f, 1.f, 1.f}, s4 = (f32x4){0.f, 0.f, 0.f, 0.f};
                if (rotw) { const float pos = (float)(row & (SEQ - 1));
#pragma unroll
                    for (int i = 0; i < 4; ++i) { const float rev = __builtin_amdgcn_fractf(pos * iv[i]); const float c = __builtin_amdgcn_cosf(rev), sn = __builtin_amdgcn_sinf(rev);
                        c4[i] = fq < 2 ? c : 1.f; s4[i] = fq < 2 ? sn : 0.f; } }
#pragma unroll
                for (int bj = 0; bj < 2; ++bj) { const f32x4 a = acc[ai][bj][m][0] * rs[ai][m], b = acc[ai][bj][m][1] * rs[ai][m];
                    const f32x4 v0 = a * c4 - b * s4, v1 = b * c4 + a * s4;
                    u32x4 w; w.x = cvt_pk_bf16(v0[0], v0[1]); w.y = cvt_pk_bf16(v0[2], v0[3]); w.z = cvt_pk_bf16(v1[0], v1[1]); w.w = cvt_pk_bf16(v1[2], v1[3]);
                    if (NS) asm volatile("" :: "v"(w)); else *(u32x4*)(rowp + (size_t)bj * 2 * T * 64) = w; } }
    }
};
typedef EpiProjT<false> EpiProj;
template <bool NS> struct EpiSwiGLUT {
    static constexpr bool PERM = true, USES_RS = true;
    bf16_t* O; int ldc; const float* rstd;
    __device__ __forceinline__ void operator()(const f32x4 (&acc)[2][2][4][2], const Unit& u, int wr, int wc, int fr, int fq, const LAS float* rsl) const {
        const int row0 = u.pm * BM + wr * 64 + fr;
        bf16_t* Ob = O + (size_t)(2 * u.pn + (wc >> 1)) * T * 64 + (wc & 1) * 32 + 8 * fq;
        float rsv[2][4];
#pragma unroll
        for (int ai = 0; ai < 2; ++ai)
#pragma unroll
            for (int m = 0; m < 4; ++m) rsv[ai][m] = rsl[ai * HALF + wr * 64 + m * 16 + fr];
#pragma unroll
        for (int ai = 0; ai < 2; ++ai)
#pragma unroll
            for (int m = 0; m < 4; ++m) { const int row = row0 + ai * HALF + m * 16; const float rs = rsv[ai][m];
                float h[8];
#pragma unroll
                for (int n = 0; n < 2; ++n)
#pragma unroll
                    for (int j = 0; j < 4; ++j) { const float g = acc[ai][0][m][n][j] * rs, up = acc[ai][1][m][n][j] * rs;
                        const float sg = __builtin_amdgcn_rcpf(1.0f + __builtin_amdgcn_exp2f(-g * LOG2E)); h[n * 4 + j] = g * sg * up; }
                u32x4 w; w.x = cvt_pk_bf16(h[0], h[1]); w.y = cvt_pk_bf16(h[2], h[3]); w.z = cvt_pk_bf16(h[4], h[5]); w.w = cvt_pk_bf16(h[6], h[7]);
                if (NS) asm volatile("" :: "v"(w)); else *(u32x4*)(Ob + (size_t)row * 64) = w; }
    }
};
typedef EpiSwiGLUT<false> EpiSwiGLU;

struct EpiNone {
    static constexpr bool PERM = true, USES_RS = false;
    __device__ __forceinline__ void operator()(const f32x4 (&acc)[2][2][4][2], const Unit&, int, int, int, int, const LAS float*) const {
#pragma unroll
        for (int a = 0; a < 2; ++a)
#pragma unroll
            for (int b = 0; b < 2; ++b)
#pragma unroll
                for (int m = 0; m < 4; ++m)
#pragma unroll
                    for (int n = 0; n < 2; ++n) asm volatile("" :: "v"(acc[a][b][m][n]));
    }
};
template <class Epi, class Sched, bool ALIGN_EPI>
__device__ __forceinline__ void gemm_phase(LAS unsigned char* lds, const Gemm g, const Sched& S, const Epi& E, int wid) {
    const int lane = fresh_lane(), tid = wid * 64 + lane, wr = wid >> 2, wc = wid & 3, fr = lane & 15, fq = lane >> 4;
    const int K = g.K, nt = K / BK, lda = g.lda, ldb = g.ldb;
    unsigned voffA[2], voffB[2];
#pragma unroll
    for (int i = 0; i < 2; ++i) { int R, C; stage_rc(tid * 16 + i * 8192, R, C); const int Rb = Epi::PERM ? ((R & ~31) + perm32(R & 31)) : R;
        voffA[i] = (unsigned)(R * lda + C) * 2u; voffB[i] = (unsigned)(Rb * ldb + C) * 2u; }
    const __amdgpu_buffer_rsrc_t rsA = __builtin_amdgcn_make_buffer_rsrc((void*)g.A, 0, 0x7fffffff, 0x00020000), rsB = __builtin_amdgcn_make_buffer_rsrc((void*)g.Bt, 0, 0x7fffffff, 0x00020000);
    const unsigned kstepA = (unsigned)g.kstepA, kstep = (unsigned)g.kstepB;
    const unsigned hstepA = (unsigned)HALF * lda * 2, hstepB = (unsigned)HALF * ldb * 2;
    const unsigned tstepA = 2 * hstepA, tstepB = 2 * hstepB;
    const unsigned ldsw = (unsigned)wid * 1024u;
    const int aoff = lds_byte(wr * 64 + fr, fq * 8), boff = lds_byte(wc * 32 + fr, fq * 8);
#define PG8_SA(b, h) (((b) * 2 + (h)) * HTB)
#define PG8_SB(b, h) ((4 + (b) * 2 + (h)) * HTB)
#define PG8_STAGE(bufoff, soff, voff) do { _Pragma("unroll") for (int _i = 0; _i < 2; ++_i) \
        __builtin_amdgcn_raw_ptr_buffer_load_lds(PG8_RSRC_OF(voff), (LAS void*)(lds + (bufoff) + ldsw + _i * 8192), 16, (voff)[_i], (unsigned)(soff), 0, 0); } while (0)
#define PG8_RSRC_OF(voff) ((voff) == voffA ? rsA : rsB)
#define PG8_LDA(dst, b, h) do { _Pragma("unroll") for (int m = 0; m < 4; ++m) _Pragma("unroll") for (int k = 0; k < 2; ++k) dst[m][k] = *(const LAS bf16x8*)(lds + PG8_SA(b, h) + aoff + m * 2048 + k * 1024); } while (0)
#define PG8_LDB(dst, b, h) do { _Pragma("unroll") for (int n = 0; n < 2; ++n) _Pragma("unroll") for (int k = 0; k < 2; ++k) dst[n][k] = *(const LAS bf16x8*)(lds + PG8_SB(b, h) + boff + n * 2048 + k * 1024); } while (0)
#define PG8_MMA(ai, bj, At, Bt) do { __builtin_amdgcn_s_setprio(1); _Pragma("unroll") for (int m = 0; m < 4; ++m) _Pragma("unroll") for (int n = 0; n < 2; ++n) _Pragma("unroll") for (int k = 0; k < 2; ++k) \
        acc[ai][bj][m][n] = __builtin_amdgcn_mfma_f32_16x16x32_bf16(Bt[n][k], At[m][k], acc[ai][bj][m][n], 0, 0, 0); __builtin_amdgcn_s_setprio(0); } while (0)
#define PG8_WAIT_V(n) asm volatile("s_waitcnt vmcnt(" #n ")" ::: "memory")
#define PG8_WAIT_L(n) asm volatile("s_waitcnt lgkmcnt(" #n ")" ::: "memory")
#define PG8_BAR __builtin_amdgcn_s_barrier()
#define PG8_SCHED __builtin_amdgcn_sched_barrier(0)
    Unit cur, nxt; int ui = 0;
    if (!S.next(0, cur)) return;
    f32x4 acc[2][2][4][2];
#pragma unroll
    for (int a = 0; a < 2; ++a)
#pragma unroll
        for (int b = 0; b < 2; ++b)
#pragma unroll
            for (int m = 0; m < 4; ++m)
#pragma unroll
                for (int n = 0; n < 2; ++n) acc[a][b][m][n] = (f32x4){0.f, 0.f, 0.f, 0.f};
    bf16x8 At[4][2], B0[2][2], B1[2][2];
    unsigned cA = (unsigned)cur.pm * tstepA, cB = (unsigned)cur.pn * tstepB;
    LAS unsigned char* rsb = lds + (RSB_OFF - RING_OFF) + wid * 2048;
#define PG8_RS_STAGE(pm_, buf_) __builtin_amdgcn_global_load_lds((const unsigned*)(E.rstd + (size_t)(pm_) * BM + lane * 4), (LAS unsigned*)(rsb + (buf_) * 1024), 16, 0, 0)
    if constexpr (Epi::USES_RS) PG8_RS_STAGE(cur.pm, 0);
    S.a_ready(cur);
    PG8_STAGE(PG8_SB(0, 0), cB, voffB); PG8_STAGE(PG8_SB(0, 1), cB + hstepB, voffB); PG8_STAGE(PG8_SA(0, 0), cA, voffA); PG8_STAGE(PG8_SA(0, 1), cA + hstepA, voffA);
    if (wr == 1) PG8_BAR;
    PG8_WAIT_V(2); PG8_BAR;
    PG8_STAGE(PG8_SB(1, 0), cB + kstep, voffB); PG8_STAGE(PG8_SA(1, 0), cA + kstepA, voffA); PG8_STAGE(PG8_SB(1, 1), cB + hstepB + kstep, voffB);
    PG8_WAIT_V(6); PG8_BAR;
    for (;;) {
        const bool has_next = S.next(ui + 1, nxt);
        const unsigned nA = has_next ? (unsigned)nxt.pm * tstepA : cA, nB = has_next ? (unsigned)nxt.pn * tstepB : cB;
        for (int t = 0; t < nt; t += 2) {
            const bool last = (t == nt - 2);
            const unsigned a1 = cA + (unsigned)(t + 1) * kstepA;
            const unsigned a2 = last ? nA : cA + (unsigned)(t + 2) * kstepA, b2 = last ? nB : cB + (unsigned)(t + 2) * kstep;
            const unsigned a3 = a2 + kstepA, b3 = b2 + kstep;
            if (last && has_next) S.a_ready(nxt);
            PG8_LDB(B0, 0, 0); PG8_LDB(B1, 0, 1); PG8_SCHED; PG8_LDA(At, 0, 0); PG8_STAGE(PG8_SA(1, 1), a1 + hstepA, voffA);
            PG8_WAIT_V(8); PG8_WAIT_L(0); PG8_BAR; PG8_MMA(0, 0, At, B0); PG8_MMA(0, 1, At, B1); PG8_BAR; PG8_SCHED;
            PG8_LDA(At, 0, 1); PG8_STAGE(PG8_SB(0, 0), b2, voffB); PG8_STAGE(PG8_SB(0, 1), b2 + hstepB, voffB); PG8_STAGE(PG8_SA(0, 0), a2, voffA);
            PG8_WAIT_V(8); PG8_WAIT_L(0); PG8_BAR; PG8_MMA(1, 0, At, B0); PG8_MMA(1, 1, At, B1); PG8_BAR; PG8_SCHED;
            PG8_LDB(B0, 1, 0); PG8_LDB(B1, 1, 1); PG8_SCHED; PG8_LDA(At, 1, 0); PG8_STAGE(PG8_SA(0, 1), a2 + hstepA, voffA);
            PG8_WAIT_V(8); PG8_WAIT_L(0); PG8_BAR; PG8_MMA(0, 0, At, B0); PG8_MMA(0, 1, At, B1); PG8_BAR; PG8_SCHED;
            PG8_LDA(At, 1, 1); PG8_STAGE(PG8_SB(1, 0), b3, voffB); PG8_STAGE(PG8_SB(1, 1), b3 + hstepB, voffB); PG8_STAGE(PG8_SA(1, 0), a3, voffA);
            PG8_WAIT_V(8); PG8_WAIT_L(0); PG8_BAR; PG8_MMA(1, 0, At, B0); PG8_MMA(1, 1, At, B1); PG8_BAR; PG8_SCHED;
        }
        if constexpr (ALIGN_EPI) { if (wr == 0) PG8_BAR; }
        E(acc, cur, wr, wc, fr, fq, (const LAS float*)(rsb + (ui & 1) * 1024)); S.done(cur);
        if constexpr (Epi::USES_RS) { if (has_next) PG8_RS_STAGE(nxt.pm, (ui + 1) & 1); }
        if (!has_next) break;
#pragma unroll
        for (int a = 0; a < 2; ++a)
#pragma unroll
            for (int b = 0; b < 2; ++b)
#pragma unroll
                for (int m = 0; m < 4; ++m)
#pragma unroll
                    for (int n = 0; n < 2; ++n) acc[a][b][m][n] = (f32x4){0.f, 0.f, 0.f, 0.f};
        cur = nxt; cA = nA; cB = nB; ++ui;
        if constexpr (ALIGN_EPI) { if (wr == 1) PG8_BAR; }
    }
    PG8_WAIT_V(0);
    if constexpr (!ALIGN_EPI) { if (wr == 0) PG8_BAR; }
    PG8_BAR;
#undef PG8_RS_STAGE
#undef PG8_RSRC_OF
#undef PG8_SA
#undef PG8_SB
#undef PG8_STAGE
#undef PG8_LDA
#undef PG8_LDB
#undef PG8_MMA
#undef PG8_WAIT_V
#undef PG8_WAIT_L
#undef PG8_BAR
#undef PG8_SCHED
}
}

#define XB_TMO      128
#define XB_XCNT(j)  (256  + 64 * (j))
#define XB_XSUB(j)  (1280 + 64 * (j))
#define XB_XGEN(j)  (2304 + 64 * (j))
#define XB_TOP      3328
#define XB_TOPGEN   3392
#define XCD_BAR_WORDS 3456
#define XB_SPIN_CAP (1u << 18)
__device__ __forceinline__ unsigned xb_ld(unsigned* p)              { return __hip_atomic_load(p, __ATOMIC_RELAXED, __HIP_MEMORY_SCOPE_AGENT); }
__device__ __forceinline__ unsigned xb_add(unsigned* p, unsigned v) { return __hip_atomic_fetch_add(p, v, __ATOMIC_RELAXED, __HIP_MEMORY_SCOPE_AGENT); }
__device__ __forceinline__ unsigned xb_xcc_id() { return (unsigned)__builtin_amdgcn_s_getreg((3 << 11) | 20) & 0xFu; }
#define XB_SPIN(cond, bar) do { unsigned _sp = 0; while (cond) { __builtin_amdgcn_s_sleep(1); \
    if ((++_sp & 255u) == 0u) { if (xb_ld(&(bar)[XB_TMO])) break; if (_sp > XB_SPIN_CAP) { atomicAdd(&(bar)[XB_TMO], 1u); break; } } } } while (0)
struct XcdBarrier { unsigned* bar; unsigned x; volatile LAS unsigned* st; };
__device__ __forceinline__ XcdBarrier xcd_barrier_post(unsigned* bar, volatile LAS unsigned* st) {
    XcdBarrier b; b.bar = bar; b.x = xb_xcc_id(); b.st = st;
    if (threadIdx.x == 0) (void)xb_add(&bar[XB_XCNT(b.x)], 1u);
    return b;
}
__device__ __forceinline__ void xcd_barrier_complete(unsigned* bar, unsigned x, unsigned& nloc, unsigned& nx) {
    const unsigned G = gridDim.x * gridDim.y * gridDim.z;
    unsigned sum, cnt, mine, sp = 0u;
    for (;;) {
        sum = 0u; cnt = 0u; mine = 0u;
#pragma unroll
        for (unsigned j = 0; j < 16; ++j) { const unsigned c = xb_ld(&bar[XB_XCNT(j)]); sum += c; cnt += (c > 0u) ? 1u : 0u; mine = (j == x) ? c : mine; }
        if (sum == G) break;
        __builtin_amdgcn_s_sleep(1);
        if ((++sp & 255u) == 0u) { if (xb_ld(&bar[XB_TMO])) break; if (sp > XB_SPIN_CAP) { atomicAdd(&bar[XB_TMO], 1u); break; } }
    }
    nloc = mine > 0u ? mine : 1u; nx = cnt > 0u ? cnt : 1u;
}
__device__ __forceinline__ void xcd_barrier(const XcdBarrier& b) {
    asm volatile("s_waitcnt vmcnt(0)" ::: "memory");
    __syncthreads();
    if (threadIdx.x == 0) {
        unsigned* bar = b.bar;
        __builtin_amdgcn_s_waitcnt(0);
        unsigned nloc = b.st[0], nx = b.st[1];
        if (nloc == 0u) { xcd_barrier_complete(bar, b.x, nloc, nx); b.st[0] = nloc; b.st[1] = nx; }
        const unsigned old = xb_add(&bar[XB_XSUB(b.x)], 1u);
        const unsigned gen = old / nloc;
        if (old + 1u == (gen + 1u) * nloc) {
            __builtin_amdgcn_fence(__ATOMIC_RELEASE, "agent");
            asm volatile("s_waitcnt vmcnt(0)" ::: "memory");
            const unsigned og = xb_add(&bar[XB_TOP], 1u);
            const unsigned tg = og / nx;
            if (og + 1u == (tg + 1u) * nx) xb_add(&bar[XB_TOPGEN], 1u);
            else XB_SPIN(xb_ld(&bar[XB_TOPGEN]) == tg, bar);
            __builtin_amdgcn_fence(__ATOMIC_ACQUIRE, "agent");
            xb_add(&bar[XB_XGEN(b.x)], 1u);
            asm volatile("s_waitcnt vmcnt(0)" ::: "memory");
        } else {
            XB_SPIN(xb_ld(&bar[XB_XGEN(b.x)]) == gen, bar);
            __builtin_amdgcn_fence(__ATOMIC_ACQUIRE, "agent");
            asm volatile("s_waitcnt vmcnt(0)" ::: "memory");
        }
    }
    __syncthreads();
}

struct Args {
    const float* in[15]; float* out; unsigned char* ws;
    float inv[8];
    int ph_lo, ph_hi, li, pad;
};
typedef const Args __attribute__((address_space(4))) KArgs;
__device__ __forceinline__ KArgs* fresh_ka() { KArgs* p = (KArgs*)__builtin_amdgcn_kernarg_segment_ptr(); asm volatile("" : "+s"(p)); return p; }
struct Frame {
    LAS unsigned char* lds;
    int lane, wave, G, gw, NGW, vcu;
    KArgs* ka;
    __device__ __forceinline__ const float* x_prompt() const { return ka->in[0]; }
    __device__ __forceinline__ const float* x_sample() const { return ka->in[1]; }
    __device__ __forceinline__ const float* g_mix_pre() const { return ka->in[2]; }
    __device__ __forceinline__ const float* g_mix_post() const { return ka->in[3]; }
    __device__ __forceinline__ const float* g_ffn_pre() const { return ka->in[4]; }
    __device__ __forceinline__ const float* g_ffn_post() const { return ka->in[5]; }
    __device__ __forceinline__ const float* w_in_ab() const { return ka->in[6]; }
    __device__ __forceinline__ const float* w_out_ab() const { return ka->in[7]; }
    __device__ __forceinline__ const float* rpb_a() const { return ka->in[8]; }
    __device__ __forceinline__ const float* sink_b() const { return ka->in[9]; }
    __device__ __forceinline__ const float* w_in_c() const { return ka->in[10]; }
    __device__ __forceinline__ const float* w_out_c() const { return ka->in[11]; }
    __device__ __forceinline__ const float* w_gate() const { return ka->in[12]; }
    __device__ __forceinline__ const float* w_up() const { return ka->in[13]; }
    __device__ __forceinline__ const float* w_down() const { return ka->in[14]; }
    __device__ __forceinline__ float* x() const { return ka->out; }
    __device__ __forceinline__ float* rope() const { return (float*)(ka->ws + WS_ROPE); }
    __device__ __forceinline__ float* rstd() const { return (float*)(ka->ws + WS_RSTD); }
    __device__ __forceinline__ float* lse() const { return (float*)(ka->ws + WS_LSE); }
    __device__ __forceinline__ bf16_t* WIN() const { return (bf16_t*)(ka->ws + WS_WIN); }
    __device__ __forceinline__ bf16_t* WOUT() const { return (bf16_t*)(ka->ws + WS_WOUT); }
    __device__ __forceinline__ bf16_t* WGU() const { return (bf16_t*)(ka->ws + WS_WGU); }
    __device__ __forceinline__ bf16_t* WD() const { return (bf16_t*)(ka->ws + WS_WD); }
    __device__ __forceinline__ bf16_t* XB() const { return (bf16_t*)(ka->ws + WS_XB); }
    __device__ __forceinline__ bf16_t* BIG() const { return (bf16_t*)(ka->ws + WS_BIG); }
};

__device__ __forceinline__ int ropeperm(int x) { const int d = x & 63; return (x & ~63) + ((d >= 4 && d < 8) ? d + 4 : (d >= 8 && d < 12) ? d - 4 : d); }
__device__ __forceinline__ void conv_map(int kind, int n, int& row, float& cs) {
    cs = 1.f; row = n;
    if (kind == 0) {
        if (n < 1024) { row = n; cs = QSCALE; }
        else if (n < 2048) row = 2048 + (n - 1024);
        else if (n < 3072) row = 3072 + (n - 2048);
        else if (n < 4096) { row = 1024 + ropeperm(n - 3072); cs = QSCALE; }
        else if (n < 4352) row = 4096 + ropeperm(n - 4096);
        else row = n;
    } else if (kind == 1) {
        const int gi = n / 3072, r = n % 3072, qkv = r >> 10, xx = r & 1023;
        row = (qkv * 3 + gi) * 1024 + (qkv < 2 ? ropeperm(xx) : xx); if (qkv == 0) cs = QSCALE;
    } else if (kind == 3) row = (n >> 7) * 256 + (n & 127);
    else if (kind == 4) row = (n >> 7) * 256 + 128 + (n & 127);
}
__device__ __forceinline__ void conv_item(const float* W, int K, int N, bf16_t* WT, int NR, const float* gain, int kind, LAS unsigned char* scr, int item, int lane) {
    const int nblk = N / 64, kb = item / nblk, nb = item % nblk, k0 = 64 * kb, n0 = 64 * nb;
    const int kq = lane >> 4, nq = 4 * (lane & 15);
    f32x4 v[16]; float gk[16];
#pragma unroll
    for (int i = 0; i < 16; ++i) v[i] = *(const f32x4*)(W + (size_t)(k0 + 4 * i + kq) * N + n0 + nq);
#pragma unroll
    for (int i = 0; i < 16; ++i) gk[i] = gain ? gain[k0 + 4 * i + kq] : 1.f;
    float cs[4];
#pragma unroll
    for (int e = 0; e < 4; ++e) { int row; conv_map(kind, n0 + nq + e, row, cs[e]); }
#pragma unroll
    for (int i = 0; i < 16; ++i) { u32x2 w; w.x = pk2(v[i][0] * gk[i] * cs[0], v[i][1] * gk[i] * cs[1]); w.y = pk2(v[i][2] * gk[i] * cs[2], v[i][3] * gk[i] * cs[3]);
        *(LAS u32x2*)(scr + (4 * i + kq) * 136 + 2 * nq) = w; }
    asm volatile("s_waitcnt lgkmcnt(0)" ::: "memory");
    const int c = lane & 7;
#pragma unroll
    for (int j = 0; j < 8; ++j) { const int n = (lane >> 3) + 8 * j; const LAS unsigned short* sp = (const LAS unsigned short*)(scr + (8 * c) * 136 + 2 * n);
        int row; float csd; conv_map(kind, n0 + n, row, csd);
        u32x4 o; o.x = (unsigned)sp[0] | ((unsigned)sp[68] << 16); o.y = (unsigned)sp[2 * 68] | ((unsigned)sp[3 * 68] << 16);
        o.z = (unsigned)sp[4 * 68] | ((unsigned)sp[5 * 68] << 16); o.w = (unsigned)sp[6 * 68] | ((unsigned)sp[7 * 68] << 16);
        *(u32x4*)(WT + ((size_t)kb * NR + row) * 64 + 8 * c) = o; }
    asm volatile("s_waitcnt lgkmcnt(0)" ::: "memory");
}
__device__ __forceinline__ void convert_layer_weights(Frame& F, int layer) {
    LAS unsigned char* scr = F.lds + RING_OFF + F.wave * 16384;
    const int i = layer >> 1; const bool even = (layer & 1) == 0;
    const int n_in = even ? N_AB : N_C, k_out = even ? 2048 : 1024;
    const int I_IN = (D / 64) * (n_in / 64), I_OUT = (k_out / 64) * (D / 64), I_G = (D / 64) * (FF / 64), I_D = (FF / 64) * (D / 64);
    const int total = I_IN + I_OUT + 2 * I_G + I_D;
    const float* w_in = even ? F.w_in_ab() + (size_t)i * D * N_AB : F.w_in_c() + (size_t)i * D * N_C;
    const float* w_out = even ? F.w_out_ab() + (size_t)i * 2048 * D : F.w_out_c() + (size_t)i * 1024 * D;
    for (int it = F.gw; it < total; it += F.NGW) {
        int r = it;
        if (r < I_IN) { conv_item(w_in, D, n_in, F.WIN(), n_in, F.g_mix_pre() + layer * D, even ? 0 : 1, scr, r, F.lane); continue; } r -= I_IN;
        if (r < I_OUT) { conv_item(w_out, k_out, D, F.WOUT(), D, nullptr, 2, scr, r, F.lane); continue; } r -= I_OUT;
        if (r < I_G) { conv_item(F.w_gate() + (size_t)layer * D * FF, D, FF, F.WGU(), N_GU, F.g_ffn_pre() + layer * D, 3, scr, r, F.lane); continue; } r -= I_G;
        if (r < I_G) { conv_item(F.w_up() + (size_t)layer * D * FF, D, FF, F.WGU(), N_GU, F.g_ffn_pre() + layer * D, 4, scr, r, F.lane); continue; } r -= I_G;
        conv_item(F.w_down() + (size_t)layer * FF * D, FF, D, F.WD(), D, nullptr, 2, scr, r, F.lane);
    }
}

__device__ __forceinline__ void prologue_rows(Frame& F) {
    for (int row = F.gw; row < T; row += F.NGW) {
        const float* src = row < 8 * SEQ ? F.x_prompt() + (size_t)row * D : F.x_sample() + (size_t)(row - 8 * SEQ) * D;
        float ss = 0.f;
#pragma unroll
        for (int j = 0; j < 4; ++j) { const int c = 8 * F.lane + 512 * j;
            const f32x4 a = *(const f32x4*)(src + c), b = *(const f32x4*)(src + c + 4);
            ss += (a[0] * a[0] + a[1] * a[1]) + (a[2] * a[2] + a[3] * a[3]) + (b[0] * b[0] + b[1] * b[1]) + (b[2] * b[2] + b[3] * b[3]);
            u32x4 w; w.x = pk2(a[0], a[1]); w.y = pk2(a[2], a[3]); w.z = pk2(b[0], b[1]); w.w = pk2(b[2], b[3]);
            *(u32x4*)(F.XB() + ((size_t)((F.lane >> 3) + 8 * j) * T + row) * 64 + 8 * (F.lane & 7)) = w; }
        ss = wave_sum(ss);
        if (F.lane == 0) F.rstd()[row] = 1.0f / sqrtf(ss * (1.0f / D) + RMS_EPS);
    }
}
template <bool FINAL, bool DUMMY> __device__ __forceinline__ void residual_rows(Frame& F, const bf16_t* mptr, int mpitch, const float* gain) {
    bf16_t* xbout = DUMMY ? (bf16_t*)F.x() : F.XB(); float* rsout = DUMMY ? F.lse() : F.rstd();
    for (int row = F.gw; row < T; row += F.NGW) {
        float mv[4][8]; float ss = 0.f;
#pragma unroll
        for (int j = 0; j < 4; ++j) { const int c = 8 * F.lane + 512 * j; const u32x4 w = *(const u32x4*)(mptr + (size_t)row * mpitch + c);
            mv[j][0] = bflo(w.x); mv[j][1] = bfhi(w.x); mv[j][2] = bflo(w.y); mv[j][3] = bfhi(w.y); mv[j][4] = bflo(w.z); mv[j][5] = bfhi(w.z); mv[j][6] = bflo(w.w); mv[j][7] = bfhi(w.w);
#pragma unroll
            for (int e = 0; e < 8; ++e) ss += mv[j][e] * mv[j][e]; }
        ss = wave_sum(ss);
        const float rs = 1.0f / sqrtf(ss * (1.0f / D) + RMS_EPS);
        float s2 = 0.f;
#pragma unroll
        for (int j = 0; j < 4; ++j) { const int c = 8 * F.lane + 512 * j;
            const size_t xo = ((size_t)((F.lane >> 3) + 8 * j) * T + row) * 64 + 8 * (F.lane & 7);
            const u32x4 xw = *(const u32x4*)(F.XB() + xo);
            const f32x4 a = (f32x4){bflo(xw.x), bfhi(xw.x), bflo(xw.y), bfhi(xw.y)}, b = (f32x4){bflo(xw.z), bfhi(xw.z), bflo(xw.w), bfhi(xw.w)};
            const f32x4 ga = *(const f32x4*)(gain + c), gb = *(const f32x4*)(gain + c + 4);
            f32x4 na, nb;
#pragma unroll
            for (int e = 0; e < 4; ++e) { na[e] = a[e] + mv[j][e] * rs * ga[e]; nb[e] = b[e] + mv[j][4 + e] * rs * gb[e]; }
            if (FINAL) { float* xo = F.x() + (size_t)row * D + c; *(f32x4*)xo = na; *(f32x4*)(xo + 4) = nb; }
            else {
                s2 += (na[0] * na[0] + na[1] * na[1]) + (na[2] * na[2] + na[3] * na[3]) + (nb[0] * nb[0] + nb[1] * nb[1]) + (nb[2] * nb[2] + nb[3] * nb[3]);
                u32x4 w; w.x = pk2(na[0], na[1]); w.y = pk2(na[2], na[3]); w.z = pk2(nb[0], nb[1]); w.w = pk2(nb[2], nb[3]);
                *(u32x4*)(xbout + xo) = w; } }
        if (!FINAL) { s2 = wave_sum(s2); if (F.lane == 0) rsout[row] = 1.0f / sqrtf(s2 * (1.0f / D) + RMS_EPS); }
    }
}

constexpr float ATT_NEG = -1e30f, ATT_FLOOR = -30000.f;
__device__ __forceinline__ void att_dma(LAS unsigned char* ring, const bf16_t* kbase, const bf16_t* vbase, long row0, int cstep, int jstride, int nch, unsigned vmask, int wave, int lane) {
    int j, ldsoff; const bf16_t* b0;
    if (wave < 4) { j = lane & 31; b0 = kbase + (2 * wave + (lane >> 5)) * 8; ldsoff = wave * 1024; }
    else { const int i = wave - 4; j = 16 * (i & 1) + (lane >> 2); b0 = vbase + 32 * (i >> 1) + 8 * (lane & 3); ldsoff = 4096 + (i >> 1) * 2048 + (i & 1) * 1024; }
    const bf16_t* p0 = b0 + (row0 + (long)j * jstride) * 64;
    for (int c = 0; c < nch; ++c)
        if ((vmask >> c) & 1u) __builtin_amdgcn_global_load_lds((const unsigned*)(p0 + (long)c * cstep * 64), (LAS unsigned*)(ring + c * 8192 + ldsoff), 16, 0, 0);
}
__device__ __forceinline__ f32x16 att_qk(const LAS unsigned char* Kc, const bf16x8 (&qr)[4], const f32x16& negm, int l31, int hi) {
    f32x16 s = negm;
#pragma unroll
    for (int d0 = 0; d0 < 4; ++d0) { const bf16x8 kf = *(const LAS bf16x8*)(Kc + (2 * d0 + hi) * 512 + l31 * 16); s = __builtin_amdgcn_mfma_f32_32x32x16_bf16(kf, qr[d0], s, 0, 0, 0); }
    return s;
}
__device__ __forceinline__ s16x4 att_vtr(const LAS unsigned char* p) { return __builtin_bit_cast(s16x4, __builtin_amdgcn_ds_read_tr16_b64_v4i16((LAS s16x4*)p)); }
constexpr float ATT_THR = 8.f;
__device__ __forceinline__ void att_softmax_pv(f32x16& s, const LAS unsigned char* Vc, float& m, f32x16& negm, float& l, f32x16& o0, f32x16& o1, bool first, int lane) {
    const int hi = lane >> 5;
    float cm = fmaxf(fmaxf(s[0], s[1]), fmaxf(s[2], s[3]));
#pragma unroll
    for (int r = 4; r < 16; r += 4) cm = fmaxf(cm, fmaxf(fmaxf(s[r], s[r + 1]), fmaxf(s[r + 2], s[r + 3])));
    { auto rr = __builtin_amdgcn_permlane32_swap(__float_as_uint(cm), __float_as_uint(cm), false, false); cm = fmaxf(__uint_as_float(rr[0]), __uint_as_float(rr[1])); }
    if (first || __any(cm > ATT_THR)) {
        const float dl = first ? fmaxf(cm, ATT_FLOOR) : fmaxf(cm, 0.f), alpha = first ? 0.f : __builtin_amdgcn_exp2f(-dl);
        m += dl; l *= alpha;
#pragma unroll
        for (int r = 0; r < 16; ++r) { s[r] -= dl; o0[r] *= alpha; o1[r] *= alpha; negm[r] = -m; }
    }
    float ps = 0.f;
#pragma unroll
    for (int r = 0; r < 16; ++r) { s[r] = __builtin_amdgcn_exp2f(s[r]); ps += s[r]; }
    l += ps;
    u32x4 pw0, pw1;
    pw0.x = cvt_pk_bf16(s[0], s[1]); pw0.y = cvt_pk_bf16(s[2], s[3]); pw0.z = cvt_pk_bf16(s[4], s[5]); pw0.w = cvt_pk_bf16(s[6], s[7]);
    pw1.x = cvt_pk_bf16(s[8], s[9]); pw1.y = cvt_pk_bf16(s[10], s[11]); pw1.z = cvt_pk_bf16(s[12], s[13]); pw1.w = cvt_pk_bf16(s[14], s[15]);
    const bf16x8 pb0 = __builtin_bit_cast(bf16x8, pw0), pb1 = __builtin_bit_cast(bf16x8, pw1);
    const LAS unsigned char* vb = Vc + (4 * hi + ((lane & 15) >> 2)) * 64 + ((lane >> 4) & 1) * 32 + (lane & 3) * 8;
#pragma unroll
    for (int d0 = 0; d0 < 2; ++d0) {
        const s16x4 a0 = att_vtr(vb + d0 * 2048), a1 = att_vtr(vb + d0 * 2048 + 512), b0 = att_vtr(vb + d0 * 2048 + 1024), b1 = att_vtr(vb + d0 * 2048 + 1536);
        const bf16x8 vf0 = (bf16x8){a0[0], a0[1], a0[2], a0[3], a1[0], a1[1], a1[2], a1[3]}, vf1 = (bf16x8){b0[0], b0[1], b0[2], b0[3], b1[0], b1[1], b1[2], b1[3]};
        if (d0 == 0) { o0 = __builtin_amdgcn_mfma_f32_32x32x16_bf16(vf0, pb0, o0, 0, 0, 0); o0 = __builtin_amdgcn_mfma_f32_32x32x16_bf16(vf1, pb1, o0, 0, 0, 0); }
        else { o1 = __builtin_amdgcn_mfma_f32_32x32x16_bf16(vf0, pb0, o1, 0, 0, 0); o1 = __builtin_amdgcn_mfma_f32_32x32x16_bf16(vf1, pb1, o1, 0, 0, 0); }
    }
}
__device__ __forceinline__ float att_half_sum(float v) { auto rr = __builtin_amdgcn_permlane32_swap(__float_as_uint(v), __float_as_uint(v), false, false); return __uint_as_float(rr[0]) + __uint_as_float(rr[1]); }
__device__ __forceinline__ void att_load_q(bf16x8 (&qr)[4], const bf16_t* qp  , int hi) {
#pragma unroll
    for (int d0 = 0; d0 < 4; ++d0) qr[d0] = *(const bf16x8*)(qp + 16 * d0 + 8 * hi);
}
__device__ __forceinline__ void att_store_o(bf16_t* op, const f32x16& o0, const f32x16& o1, float f, int hi) {
#pragma unroll
    for (int g = 0; g < 4; ++g) {
        u32x2 w0, w1; w0.x = cvt_pk_bf16(o0[4 * g] * f, o0[4 * g + 1] * f); w0.y = cvt_pk_bf16(o0[4 * g + 2] * f, o0[4 * g + 3] * f);
        w1.x = cvt_pk_bf16(o1[4 * g] * f, o1[4 * g + 1] * f); w1.y = cvt_pk_bf16(o1[4 * g + 2] * f, o1[4 * g + 3] * f);
        *(u32x2*)(op + 8 * g + 4 * hi) = w0; *(u32x2*)(op + 32 + 8 * g + 4 * hi) = w1; }
}
__device__ __forceinline__ void att_tri_mask(f32x16& s, int edge, int dq  ) {
#pragma unroll
    for (int r = 0; r < 16; ++r) { const int jj = (r & 3) + 8 * (r >> 2) + dq; const bool ok = edge < 0 ? (jj >= 0) : (jj <= 0); s[r] = ok ? s[r] : ATT_NEG; }
}

template <bool DUMMY> __device__ __forceinline__ void mfma_attn_b(Frame& F, int li) {
    LAS unsigned char* ring = F.lds + RING_OFF;
    const int lane = F.lane, l31 = lane & 31, hi = lane >> 5, wave = F.wave;
    for (int u = F.vcu; u < NSEQ * 4 * 64; u += F.G) {
        const int blk = u & 63, kvh = (u >> 6) & 3, b = u >> 8, t0 = blk * 64, sb = b * SEQ;
        unsigned vmask = 0u;
        for (int c = 0; c < 10; ++c) { const int kt = t0 - 128 + 32 * c; if (kt >= 0 && kt < SEQ) vmask |= 1u << c; }
        att_dma(ring, F.BIG() + (64 + kvh) * (size_t)T * 64, F.BIG() + (68 + kvh) * (size_t)T * 64, (long)sb + t0 - 128, 32, 1, 10, vmask, wave, lane);
        const int qt = wave & 1, head = kvh * 4 + (wave >> 1);
        const size_t qoff = ((size_t)(16 + head) * T + (sb + t0 + 32 * qt + l31)) * 64; bf16_t* qp = F.BIG() + qoff;
        bf16x8 qr[4]; att_load_q(qr, qp, hi);
        asm volatile("s_waitcnt vmcnt(0)" ::: "memory"); __syncthreads();
        float m = F.sink_b()[li * 16 + head] * LOG2E, l = hi == 0 ? 1.f : 0.f;
        f32x16 o0, o1, negm;
#pragma unroll
        for (int r = 0; r < 16; ++r) { o0[r] = 0.f; o1[r] = 0.f; negm[r] = -m; }
        for (int c = qt; c <= qt + 8; ++c) {
            if (!((vmask >> c) & 1u)) continue;
            f32x16 s = att_qk(ring + c * 8192, qr, negm, l31, hi);
            const int rel = c - qt - 4;
            if (rel == -4) att_tri_mask(s, -1, 4 * hi - l31); else if (rel == 4) att_tri_mask(s, 1, 4 * hi - l31);
            att_softmax_pv(s, ring + c * 8192 + 4096, m, negm, l, o0, o1, false, lane);
        }
        const float lt = att_half_sum(l);
        att_store_o(DUMMY ? (bf16_t*)F.x() + qoff : qp, o0, o1, 1.0f / lt, hi);
        __syncthreads();
    }
}
template <bool DUMMY> __device__ __forceinline__ void mfma_attn_a(Frame& F, int li) {
    LAS unsigned char* ring = F.lds + RING_OFF;
    LAS float* biasT = (LAS float*)(F.lds + BIAS_OFF);
    const int lane = F.lane, l31 = lane & 31, hi = lane >> 5, wave = F.wave;
    for (int u = F.vcu; u < NSEQ * 16 * 32; u += F.G) {
        const int C4 = u & 3, R = (u >> 2) & 7, h = (u >> 5) & 15, b = u >> 9, sb = b * SEQ;
        const int kr0 = min(max(8 * R - 4, 0), 56), krl = min(max(8 * R + 3, 0), 56) + 7, nch = krl - kr0 + 1;
        const int kc0 = min(max(16 * C4 - 8, 0), 32);
        att_dma(ring, F.BIG() + (32 + h) * (size_t)T * 64, F.BIG() + (48 + h) * (size_t)T * 64, (long)sb + kr0 * 64 + kc0, 64, 1, nch, 0xffffu, wave, lane);
        for (int i = wave * 64 + lane; i < 465; i += NWAVES * 64) biasT[i] = F.rpb_a()[(size_t)(li * 16 + h) * 465 + i] * LOG2E;
        const int wq = wave & 3;
        const int qrow_g = 8 * R + 2 * wq + (l31 >> 4), qcol_g = 16 * C4 + (l31 & 15);
        const size_t qoff = ((size_t)h * T + (sb + qrow_g * 64 + qcol_g)) * 64; bf16_t* qp = F.BIG() + qoff;
        bf16x8 qr[4]; att_load_q(qr, qp, hi);
        asm volatile("s_waitcnt vmcnt(0)" ::: "memory"); __syncthreads();
        if (wave < 4) {
            const int rs_l = min(max(qrow_g - 4, 0), 56), cs_l = min(max(qcol_g - 8, 0), 48);
            const int jb_l = 4 * hi - (cs_l - kc0), bbase_l = kc0 - qcol_g + 15 + 4 * hi;
            const int c_lo = min(max(8 * R + 2 * wq - 4, 0), 56) - kr0, c_hi = min(max(8 * R + 2 * wq + 1 - 4, 0), 56) + 7 - kr0;
            float m = 0.f, l = 0.f;
            f32x16 o0, o1, negm;
#pragma unroll
            for (int r = 0; r < 16; ++r) { o0[r] = 0.f; o1[r] = 0.f; negm[r] = 0.f; }
            for (int ci = c_lo; ci <= c_hi; ++ci) {
                const int c = ci == c_lo ? c_lo + 1 : ci == c_lo + 1 ? c_lo : ci;
                f32x16 s = att_qk(ring + c * 8192, qr, negm, l31, hi);
                const int kr = kr0 + c; const bool rowok = (kr >= rs_l) && (kr < rs_l + 8);
                const int bo = (kr - qrow_g + 7) * 31 + bbase_l;
                float bv[16];
#pragma unroll
                for (int r = 0; r < 16; ++r) bv[r] = biasT[min(max(bo + (r & 3) + 8 * (r >> 2), 0), 464)];
#pragma unroll
                for (int r = 0; r < 16; ++r) { const int jj = (r & 3) + 8 * (r >> 2); const bool ok = rowok && ((unsigned)(jj + jb_l) < 16u); s[r] = ok ? s[r] + bv[r] : ATT_NEG; }
                att_softmax_pv(s, ring + c * 8192 + 4096, m, negm, l, o0, o1, ci == c_lo, lane);
            }
            const float lt = att_half_sum(l);
            att_store_o(DUMMY ? (bf16_t*)F.x() + qoff : qp, o0, o1, 1.0f / lt, hi);
        }
        __syncthreads();
    }
}
template <int PASS, bool DUMMY> __device__ __forceinline__ void mfma_attn_c(Frame& F) {
    LAS unsigned char* ring = F.lds + RING_OFF;
    const int lane = F.lane, l31 = lane & 31, hi = lane >> 5, wave = F.wave;
    const int nunits = PASS == 1 ? 2 * 2560 : 2560;
    for (int u = F.vcu; u < nunits; u += F.G) {
        const int g = PASS == 1 ? 1 + u / 2560 : 0, v = u % 2560, b = v >> 8, h = (v >> 4) & 15, sub = v & 15;
        const int d = g == 0 ? 1 : g == 1 ? 4 : 16, lm = SEQ / d, res = sub % d, m0 = 256 * (sub / d), sb = b * SEQ;
        unsigned vmask = 0u;
        for (int c = 0; c < 12; ++c) { const int p = m0 - 64 + 32 * c; if (p >= 0 && p < lm) vmask |= 1u << c; }
        att_dma(ring, F.BIG() + (48 + g * 16 + h) * (size_t)T * 64, F.BIG() + (96 + g * 16 + h) * (size_t)T * 64, (long)sb + (long)(m0 - 64) * d + res, 32 * d, d, 12, vmask, wave, lane);
        const size_t qrow = (size_t)(sb + (m0 + 32 * wave + l31) * d + res);
        const size_t qoff = ((size_t)(g * 16 + h) * T + qrow) * 64; bf16_t* qp = F.BIG() + qoff;
        bf16x8 qr[4]; att_load_q(qr, qp, hi);
        asm volatile("s_waitcnt vmcnt(0)" ::: "memory"); __syncthreads();
        float m = 0.f, l = 0.f; bool first = true;
        f32x16 o0, o1, negm;
#pragma unroll
        for (int r = 0; r < 16; ++r) { o0[r] = 0.f; o1[r] = 0.f; negm[r] = 0.f; }
        for (int c = wave; c <= wave + 4; ++c) {
            if (!((vmask >> c) & 1u)) continue;
            f32x16 s = att_qk(ring + c * 8192, qr, negm, l31, hi);
            const int rel = c - wave - 2;
            if (rel == -2) att_tri_mask(s, -1, 4 * hi - l31); else if (rel == 2) att_tri_mask(s, 1, 4 * hi - l31);
            att_softmax_pv(s, ring + c * 8192 + 4096, m, negm, l, o0, o1, first, lane); first = false;
        }
        const float lt = att_half_sum(l);
        const float L = m + __builtin_amdgcn_logf(lt);
        if (PASS == 1) {
            att_store_o(DUMMY ? (bf16_t*)F.x() + qoff : qp, o0, o1, 1.0f / lt, hi);
            if (hi == 0) F.lse()[((size_t)(g - 1) * T + qrow) * 16 + h] = L;
        } else {
            const float L1 = F.lse()[(qrow) * 16 + h], L2 = F.lse()[((size_t)T + qrow) * 16 + h];
            const float Lm = fmaxf(L, fmaxf(L1, L2));
            const float w0 = __builtin_amdgcn_exp2f(L - Lm), w1 = __builtin_amdgcn_exp2f(L1 - Lm), w2 = __builtin_amdgcn_exp2f(L2 - Lm), iw = 1.0f / (w0 + w1 + w2);
            const float f0 = w0 * iw / lt, f1 = w1 * iw, f2 = w2 * iw;
            const bf16_t* p1 = qp + 16 * (size_t)T * 64; const bf16_t* p2 = qp + 32 * (size_t)T * 64;
#pragma unroll
            for (int g4 = 0; g4 < 4; ++g4)
#pragma unroll
                for (int d0 = 0; d0 < 2; ++d0) {
                    const u32x2 a = *(const u32x2*)(p1 + 32 * d0 + 8 * g4 + 4 * hi), c2 = *(const u32x2*)(p2 + 32 * d0 + 8 * g4 + 4 * hi);
                    const f32x16& o = d0 == 0 ? o0 : o1;
                    const float r0 = o[4 * g4] * f0 + bflo(a.x) * f1 + bflo(c2.x) * f2, r1 = o[4 * g4 + 1] * f0 + bfhi(a.x) * f1 + bfhi(c2.x) * f2;
                    const float r2 = o[4 * g4 + 2] * f0 + bflo(a.y) * f1 + bflo(c2.y) * f2, r3 = o[4 * g4 + 3] * f0 + bfhi(a.y) * f1 + bfhi(c2.y) * f2;
                    u32x2 w; w.x = cvt_pk_bf16(r0, r1); w.y = cvt_pk_bf16(r2, r3);
                    *(u32x2*)((DUMMY ? (bf16_t*)F.x() + qoff : qp) + 32 * d0 + 8 * g4 + 4 * hi) = w; }
        }
        __syncthreads();
    }
}

constexpr int NPH = 1 + DEPTH * 8;
__global__ void __launch_bounds__(NWAVES * 64, 2) fwd(Args args) {
    extern __shared__ __attribute__((aligned(16))) unsigned char lds[];
    Frame F;
    F.lds = (LAS unsigned char*)lds;
    F.wave = __builtin_amdgcn_readfirstlane((int)threadIdx.x >> 6); F.lane = fresh_lane(); F.ka = fresh_ka();
    F.G = gridDim.x; F.gw = blockIdx.x * NWAVES + F.wave; F.NGW = F.G * NWAVES;
    F.vcu = (F.G % 8 == 0) ? (int)(blockIdx.x % 8) * (F.G / 8) + (int)(blockIdx.x / 8) : (int)blockIdx.x;
    F.ka = fresh_ka();
    unsigned char* ws = args.ws;
    volatile LAS unsigned* MISC = (volatile LAS unsigned*)(F.lds + MISC_OFF);
    for (int u = F.wave * 64 + F.lane; u < (LDS_BYTES - LDSCTL_OFF) / 4; u += NWAVES * 64) ((LAS unsigned*)(F.lds + LDSCTL_OFF))[u] = 0u;
    __syncthreads();
    unsigned* barw = (unsigned*)(ws + WS_CTL) + CW_BAR;
    XcdBarrier bar; bar.bar = barw; bar.x = 0; bar.st = nullptr;
    if (!MK_PER_PHASE) bar = xcd_barrier_post(barw, MISC + 8);
    const int lo = args.ph_lo, hi = args.ph_hi;
#define IN(k) (lo <= (k) && (k) < hi)
#define SEAM(k) do { if (!MK_PER_PHASE) { if (IN(k) && IN((k) + 1)) xcd_barrier(bar); } } while (0)

    if (IN(0)) {
        F.lane = fresh_lane(); F.ka = fresh_ka();
        prologue_rows(F);
        for (int rep = 0; rep < (PROBE == 4 ? 2 : 1); ++rep) convert_layer_weights(F, 0);
    }
    SEAM(0);
    for (int layer = 0; layer < DEPTH; ++layer) {
        const int pb = 1 + 8 * layer; const bool even = (layer & 1) == 0; const int li = layer >> 1;
        const int n_in = even ? N_AB : N_C;
        if (IN(pb + 0)) { F.ka = fresh_ka();
            pg8::Gemm g{F.XB(), F.WIN(), T, n_in, D, 64, 64, (size_t)T * 128, (size_t)n_in * 128}; pg8::StaticOrder S; S.init(T, n_in, F.G, (int)blockIdx.x);
            pg8::EpiProj E{F.BIG(), F.rstd(), even ? ((0xFull << 4) | (1ull << 16)) : ((1ull << 24) - 1ull), F.ka->inv[0], F.ka->inv[1], F.ka->inv[2], F.ka->inv[3], F.ka->inv[4], F.ka->inv[5], F.ka->inv[6], F.ka->inv[7]};
            if (PROBE == 5) { pg8::EpiNone E0; pg8::gemm_phase<pg8::EpiNone, pg8::StaticOrder, true>(F.lds + RING_OFF, g, S, E0, F.wave); }
            if (PROBE == 6) { pg8::EpiProjT<true> E0{E.O, E.rstd, E.ropemask, E.r0, E.r1, E.r2, E.r3, E.r4, E.r5, E.r6, E.r7}; pg8::gemm_phase<pg8::EpiProjT<true>, pg8::StaticOrder, true>(F.lds + RING_OFF, g, S, E0, F.wave); }
            for (int rep = 0; rep < (PROBE == 1 ? 2 : 1); ++rep) pg8::gemm_phase<pg8::EpiProj, pg8::StaticOrder, true>(F.lds + RING_OFF, g, S, E, F.wave);
        }
        SEAM(pb + 0);
        if (IN(pb + 1)) { F.lane = fresh_lane(); F.ka = fresh_ka();
            if (even) { if (PROBE == 2 || PROBE == 21) mfma_attn_a<true>(F, li); if (PROBE == 2 || PROBE == 22) mfma_attn_b<true>(F, li); mfma_attn_a<false>(F, li); mfma_attn_b<false>(F, li); }
            else { if (PROBE == 2 || PROBE == 23) mfma_attn_c<1, true>(F); mfma_attn_c<1, false>(F); }
        }
        if (!even) SEAM(pb + 1);
        if (IN(pb + 2) && !even) { F.lane = fresh_lane(); F.ka = fresh_ka(); if (PROBE == 2 || PROBE == 24) mfma_attn_c<2, true>(F); mfma_attn_c<2, false>(F); }
        SEAM(pb + 2);
        if (IN(pb + 3)) { F.ka = fresh_ka();
            const int k_out = even ? 2048 : 1024;
            pg8::Gemm g{F.BIG(), F.WOUT(), T, D, k_out, 64, 64, (size_t)T * 128, (size_t)D * 128};     pg8::StaticOrder S; S.init(T, D, F.G, (int)blockIdx.x);
            pg8::EpiPlain E{F.BIG() + (size_t)(even ? 32 : 16) * T * 64, D};
            if (PROBE == 5) { pg8::EpiNone E0; pg8::gemm_phase<pg8::EpiNone, pg8::StaticOrder, true>(F.lds + RING_OFF, g, S, E0, F.wave); }
            if (PROBE == 6) { pg8::EpiPlainT<true> E0{E.O, E.ldc}; pg8::gemm_phase<pg8::EpiPlainT<true>, pg8::StaticOrder, true>(F.lds + RING_OFF, g, S, E0, F.wave); }
            for (int rep = 0; rep < (PROBE == 1 ? 2 : 1); ++rep) pg8::gemm_phase<pg8::EpiPlain, pg8::StaticOrder, true>(F.lds + RING_OFF, g, S, E, F.wave);
        }
        SEAM(pb + 3);
        if (IN(pb + 4)) { F.lane = fresh_lane(); F.ka = fresh_ka(); const bf16_t* mp = F.BIG() + (size_t)(even ? 32 : 16) * T * 64;
            if (PROBE == 3) residual_rows<false, true>(F, mp, D, F.g_mix_post() + layer * D); residual_rows<false, false>(F, mp, D, F.g_mix_post() + layer * D); }
        SEAM(pb + 4);
        if (IN(pb + 5)) { F.ka = fresh_ka();
            pg8::Gemm g{F.XB(), F.WGU(), T, N_GU, D, 64, 64, (size_t)T * 128, (size_t)N_GU * 128}; pg8::StaticOrder S; S.init(T, N_GU, F.G, (int)blockIdx.x);
            pg8::EpiSwiGLU E{F.BIG(), FF, F.rstd()};
            if (PROBE == 5) { pg8::EpiNone E0; pg8::gemm_phase<pg8::EpiNone, pg8::StaticOrder, true>(F.lds + RING_OFF, g, S, E0, F.wave); }
            if (PROBE == 6) { pg8::EpiSwiGLUT<true> E0{E.O, E.ldc, E.rstd}; pg8::gemm_phase<pg8::EpiSwiGLUT<true>, pg8::StaticOrder, true>(F.lds + RING_OFF, g, S, E0, F.wave); }
            for (int rep = 0; rep < (PROBE == 1 ? 2 : 1); ++rep) pg8::gemm_phase<pg8::EpiSwiGLU, pg8::StaticOrder, true>(F.lds + RING_OFF, g, S, E, F.wave);
        }
        SEAM(pb + 5);
        if (IN(pb + 6)) { F.ka = fresh_ka();
            pg8::Gemm g{F.BIG(), F.WD(), T, D, FF, 64, 64, (size_t)T * 128, (size_t)D * 128}; pg8::StaticOrder S; S.init(T, D, F.G, (int)blockIdx.x);
            pg8::EpiPlain E{F.BIG() + (size_t)T * FF, D};
            if (PROBE == 5) { pg8::EpiNone E0; pg8::gemm_phase<pg8::EpiNone, pg8::StaticOrder, true>(F.lds + RING_OFF, g, S, E0, F.wave); }
            if (PROBE == 6) { pg8::EpiPlainT<true> E0{E.O, E.ldc}; pg8::gemm_phase<pg8::EpiPlainT<true>, pg8::StaticOrder, true>(F.lds + RING_OFF, g, S, E0, F.wave); }
            for (int rep = 0; rep < (PROBE == 1 ? 2 : 1); ++rep) pg8::gemm_phase<pg8::EpiPlain, pg8::StaticOrder, true>(F.lds + RING_OFF, g, S, E, F.wave);
        }
        SEAM(pb + 6);
        if (IN(pb + 7)) { F.lane = fresh_lane(); F.ka = fresh_ka(); const bf16_t* fp = F.BIG() + (size_t)T * FF;
            if (layer + 1 < DEPTH) { if (PROBE == 3) residual_rows<false, true>(F, fp, D, F.g_ffn_post() + layer * D); residual_rows<false, false>(F, fp, D, F.g_ffn_post() + layer * D); }
            else residual_rows<true, false>(F, fp, D, F.g_ffn_post() + layer * D);
            if (layer + 1 < DEPTH) { for (int rep = 0; rep < (PROBE == 4 ? 2 : 1); ++rep) { F.lane = fresh_lane(); F.ka = fresh_ka(); convert_layer_weights(F, layer + 1); } } }
        SEAM(pb + 7);
    }
#undef IN
#undef SEAM
}

extern "C" void kernel_launch(void* const* d_in, const int* in_sizes, int n_in, void* d_out, int out_size, void* d_ws, size_t ws_size, hipStream_t stream) {
    static int grid = 0;
    if (grid == 0) {
        if (n_in != 15 || out_size != T * D || ws_size < WS_END) { fprintf(stderr, "kernel_launch: unexpected shapes (n_in %d, out %d, ws %zu); nothing launched\n", n_in, out_size, ws_size); grid = -1; return; }
        int dev = 0, cus = 0, per_cu = 0;
        if (hipGetDevice(&dev) != hipSuccess || hipDeviceGetAttribute(&cus, hipDeviceAttributeMultiprocessorCount, dev) != hipSuccess) { grid = -1; return; }
        if (hipFuncSetAttribute((const void*)fwd, hipFuncAttributeMaxDynamicSharedMemorySize, LDS_BYTES) != hipSuccess) { fprintf(stderr, "kernel_launch: hipFuncSetAttribute failed\n"); grid = -1; return; }
        if (hipOccupancyMaxActiveBlocksPerMultiprocessor(&per_cu, (const void*)fwd, NWAVES * 64, LDS_BYTES) != hipSuccess || per_cu < 1)
            fprintf(stderr, "kernel_launch: note: occupancy query reports %d workgroups per CU\n", per_cu);
        (void)hipGetLastError();
        grid = cus;
    }
    if (grid < 0) return;
    if (hipMemsetAsync((char*)d_ws + WS_CTL, 0, CTL_ZERO_BYTES, stream) != hipSuccess) return;
    Args a{};
    for (int i = 0; i < 15; ++i) a.in[i] = (const float*)d_in[i];
    a.out = (float*)d_out; a.ws = (unsigned char*)d_ws;
    { const float la = (float)(-log(500000.0)); for (int j = 0; j < 8; ++j) { const float arg = (la * (float)j) * 0.125f; const float inv = (float)exp((double)arg); a.inv[j] = (float)((double)inv / 6.283185307179586476925); } }
#if MK_PER_PHASE
    for (int p = 0; p < NPH; ++p) { a.ph_lo = p; a.ph_hi = p + 1; a.li = p; hipLaunchKernelGGL(fwd, dim3(grid), dim3(NWAVES * 64), LDS_BYTES, stream, a); }
#else
    a.ph_lo = 0; a.ph_hi = NPH; a.li = 0;
    hipLaunchKernelGGL(fwd, dim3(grid), dim3(NWAVES * 64), LDS_BYTES, stream, a);
#endif
    const hipError_t le = hipPeekAtLastError();
    if (le != hipSuccess) fprintf(stderr, "kernel_launch: launch failed: %s\n", hipGetErrorName(le));
}
```
